# Optimizing an MI355X kernel written in HIP

```python
import jax, jax.numpy as jnp
from jax import lax
import numpy as np

D_MODEL = 1024
BATCH = 2
SEQ = 8192
DEPTH = 2
DEC_BATCH = 128
DEC_SEQ = 4
PAST_LEN = 8192
PAGE_SIZE = 128

N_A_LAYERS = DEPTH // 2
N_B_LAYERS = DEPTH - N_A_LAYERS
ML_HEADS = 4
ML_DK = D_MODEL // 8
ML_DV = D_MODEL // 4
ML_CHUNK = 64
ATT_Q_HEADS = 16
ATT_KV_HEADS = 4
ATT_GROUP = ATT_Q_HEADS // ATT_KV_HEADS
ATT_HD = 64
WINDOW = 128
ROT_DIM = ATT_HD // 4
ROPE_THETA = 500000.0
D_FF = 2816
ALPHA = (2 * DEPTH) ** 0.25
BETA = (8 * DEPTH) ** -0.25
LN_EPS = 1e-5
N_MOD = 9
F32 = jnp.float32

kernel_name = 'yoco_mlstm_swa_sink_macaron_step'


def layer_norm(x, g, b):
    xf = x.astype(F32)
    mu = jnp.mean(xf, -1, keepdims=True)
    var = jnp.mean(jnp.square(xf - mu), -1, keepdims=True)
    return ((xf - mu) * lax.rsqrt(var + LN_EPS) * g.astype(F32) + b.astype(F32)).astype(x.dtype)


def modulate(x, shift, scale):
    return x * (1.0 + scale[:, None, :]) + shift[:, None, :]


def swiglu(x, w_up, w_down):
    a, u = jnp.split(x @ w_up, 2, axis=-1)
    return (jax.nn.silu(a) * u) @ w_down


def rotary(x, pos):
    half = ROT_DIM // 2
    inv_freq = ROPE_THETA ** (-jnp.arange(half, dtype=F32) * 2.0 / ROT_DIM)
    ang = pos.astype(F32)[:, None] * inv_freq[None, :]
    cos = jnp.cos(ang)[:, None, :].astype(x.dtype)
    sin = jnp.sin(ang)[:, None, :].astype(x.dtype)
    x1 = x[..., :half]
    x2 = x[..., half:ROT_DIM]
    return jnp.concatenate([x1 * cos - x2 * sin, x2 * cos + x1 * sin, x[..., ROT_DIM:]], axis=-1)


def mlstm_chunkwise(q, k, v, i_pre, log_f, C0, n0, m0, chunk):
    B, S, H, DK = q.shape
    DV = v.shape[-1]
    nc = S // chunk

    def blocks(a):
        return a.astype(F32).reshape(B, nc, chunk, H, a.shape[-1]).transpose(1, 0, 3, 2, 4)

    def gate_blocks(a):
        return a.astype(F32).reshape(B, nc, chunk, H).transpose(1, 0, 3, 2)

    causal = jnp.tril(jnp.ones((chunk, chunk), dtype=bool))

    def step(carry, inp):
        C, n, m = carry
        qc, kc, vc, ic, fc = inp
        b = jnp.cumsum(fc, axis=-1)
        log_w = b[..., :, None] - b[..., None, :] + ic[..., None, :]
        log_w = jnp.where(causal, log_w, -jnp.inf)
        log_init = b + m[..., None]
        m_t = jnp.maximum(log_init, jnp.max(log_w, axis=-1))
        w = jnp.exp(log_w - m_t[..., None])
        w_init = jnp.exp(log_init - m_t)
        s = jnp.einsum('bhtd,bhsd->bhts', qc, kc) * w
        num = jnp.einsum('bhts,bhsv->bhtv', s, vc) + w_init[..., None] * jnp.einsum('bhtd,bhdv->bhtv', qc, C)
        den = jnp.sum(s, axis=-1) + w_init * jnp.einsum('bhtd,bhd->bht', qc, n)
        h = num / jnp.maximum(jnp.abs(den), jnp.exp(-m_t))[..., None]
        m_new = m_t[..., -1]
        w_end = jnp.exp(b[..., -1:] - b + ic - m_new[..., None])
        decay = jnp.exp(b[..., -1] + m - m_new)
        C_new = decay[..., None, None] * C + jnp.einsum('bhs,bhsd,bhsv->bhdv', w_end, kc, vc)
        n_new = decay[..., None] * n + jnp.einsum('bhs,bhsd->bhd', w_end, kc)
        return (C_new, n_new, m_new), h

    carry0 = (C0.astype(F32), n0.astype(F32), m0.astype(F32))
    (C, n, m), hs = lax.scan(step, carry0, (blocks(q), blocks(k), blocks(v), gate_blocks(i_pre), gate_blocks(log_f)))
    hs = hs.transpose(1, 0, 3, 2, 4).reshape(B, S, H, DV)
    return hs, (C, n, m)


def mlstm_mixer(h, w_in, b_gates, norm_w, w_out, C0, n0, m0, chunk):
    B, S, _ = h.shape
    HQK = ML_HEADS * ML_DK
    HV = ML_HEADS * ML_DV
    proj = h @ w_in
    q = proj[..., :HQK].reshape(B, S, ML_HEADS, ML_DK)
    k = proj[..., HQK:2 * HQK].reshape(B, S, ML_HEADS, ML_DK) * (ML_DK ** -0.5)
    v = proj[..., 2 * HQK:2 * HQK + HV].reshape(B, S, ML_HEADS, ML_DV)
    o = proj[..., 2 * HQK + HV:2 * HQK + 2 * HV]
    gates = proj[..., 2 * HQK + 2 * HV:].astype(F32) + b_gates.astype(F32)
    i_pre = gates[..., :ML_HEADS]
    log_f = jax.nn.log_sigmoid(gates[..., ML_HEADS:])
    hh, state = mlstm_chunkwise(q, k, v, i_pre, log_f, C0, n0, m0, chunk)
    mu = jnp.mean(hh, -1, keepdims=True)
    var = jnp.mean(jnp.square(hh - mu), -1, keepdims=True)
    hn = (hh - mu) * lax.rsqrt(var + LN_EPS) * norm_w.astype(F32).reshape(ML_HEADS, ML_DV)
    y = hn.reshape(B, S, HV).astype(h.dtype) * jax.nn.sigmoid(o)
    return y @ w_out, state


def shared_kv(x, c_act, ada_w, ada_b, w_kv, pos):
    B, S, _ = x.shape
    mods = (c_act @ ada_w + ada_b).reshape(B, 2, D_MODEL)
    hkv = modulate(x, mods[:, 0], mods[:, 1])
    k, v = jnp.split(hkv @ w_kv, 2, axis=-1)
    k = rotary(k.reshape(B, S, ATT_KV_HEADS, ATT_HD), pos)
    return k, v.reshape(B, S, ATT_KV_HEADS, ATT_HD)


def window_mask(qpos, kpos):
    kp = kpos[..., None, :]
    qp = qpos[..., :, None]
    return (kp <= qp) & (kp > qp - WINDOW) & (kp >= 0)


def sink_softmax(s, sinks):
    sink = sinks.astype(F32).reshape(ATT_KV_HEADS, ATT_GROUP, 1, 1)
    mx = jnp.maximum(jnp.max(s, axis=-1, keepdims=True), sink)
    p = jnp.exp(s - mx)
    return p / (jnp.sum(p, axis=-1, keepdims=True) + jnp.exp(sink - mx))


def swa_banded(q, k, v, sinks):
    B, S, _, _ = q.shape
    nb = S // WINDOW
    qb = q.reshape(B, nb, WINDOW, ATT_KV_HEADS, ATT_GROUP, ATT_HD).astype(F32)
    kb = k.reshape(B, nb, WINDOW, ATT_KV_HEADS, ATT_HD)
    vb = v.reshape(B, nb, WINDOW, ATT_KV_HEADS, ATT_HD)
    prev = lambda a: jnp.concatenate([jnp.zeros_like(a[:, :1]), a[:, :-1]], axis=1)
    kk = jnp.concatenate([prev(kb), kb], axis=2).astype(F32)
    vv = jnp.concatenate([prev(vb), vb], axis=2)
    qpos = jnp.arange(nb)[:, None] * WINDOW + jnp.arange(WINDOW)[None, :]
    kpos = qpos[:, :1] - WINDOW + jnp.arange(2 * WINDOW)[None, :]
    mask = window_mask(qpos, kpos)
    s = jnp.einsum('bnqkgd,bnskd->bnkgqs', qb, kk) * (ATT_HD ** -0.5)
    s = jnp.where(mask[None, :, None, None], s, -jnp.inf)
    p = sink_softmax(s, sinks)
    o = jnp.einsum('bnkgqs,bnskd->bnqkgd', p.astype(vv.dtype), vv)
    return o.reshape(B, S, ATT_Q_HEADS * ATT_HD)


def swa_cached(q, k_new, v_new, k_buf, v_buf, sinks):
    B, T, _, _ = q.shape
    Wb = k_buf.shape[1]
    kk = jnp.concatenate([k_buf.astype(k_new.dtype), k_new], axis=1).astype(F32)
    vv = jnp.concatenate([v_buf.astype(v_new.dtype), v_new], axis=1)
    qpos = PAST_LEN + jnp.arange(T)
    kpos = PAST_LEN - Wb + jnp.arange(Wb + T)
    mask = window_mask(qpos, kpos)
    qg = q.reshape(B, T, ATT_KV_HEADS, ATT_GROUP, ATT_HD).astype(F32)
    s = jnp.einsum('btkgd,bskd->bkgts', qg, kk) * (ATT_HD ** -0.5)
    s = jnp.where(mask, s, -jnp.inf)
    p = sink_softmax(s, sinks)
    o = jnp.einsum('bkgts,bskd->btkgd', p.astype(vv.dtype), vv)
    return o.reshape(B, T, ATT_Q_HEADS * ATT_HD)


def trunk(x, c, is_prompt, C0, n0, m0, k_buf, v_buf, ada_w, ada_b, ffn1_up, ffn1_down, ffn2_up, ffn2_down,
          ln_g, ln_b, ml_w_in, ml_b_gates, ml_norm_w, ml_w_out, kv_ada_w, kv_ada_b, kv_w,
          att_w_q, att_sinks, att_w_o):
    B, S, _ = x.shape
    if is_prompt:
        pos = jnp.arange(S, dtype=jnp.int32)
        chunk = min(ML_CHUNK, S)
    else:
        pos = PAST_LEN + jnp.arange(S, dtype=jnp.int32)
        chunk = S
    c_act = jax.nn.silu(c)
    Cs, ns, ms = [], [], []
    k_sh, v_sh = None, None
    for layer in range(DEPTH):
        mods = (c_act @ ada_w[layer] + ada_b[layer]).reshape(B, N_MOD, D_MODEL)
        f1 = swiglu(modulate(x, mods[:, 0], mods[:, 1]), ffn1_up[layer], ffn1_down[layer])
        x = layer_norm(ALPHA * x + 0.5 * mods[:, 2, None, :] * f1, ln_g[layer, 0], ln_b[layer, 0])
        h = modulate(x, mods[:, 3], mods[:, 4])
        if layer < N_A_LAYERS:
            y, (C, n, m) = mlstm_mixer(h, ml_w_in[layer], ml_b_gates[layer], ml_norm_w[layer], ml_w_out[layer],
                                       C0[layer], n0[layer], m0[layer], chunk)
            Cs.append(C)
            ns.append(n)
            ms.append(m)
        else:
            j = layer - N_A_LAYERS
            q = rotary((h @ att_w_q[j]).reshape(B, S, ATT_Q_HEADS, ATT_HD), pos)
            if is_prompt:
                a = swa_banded(q, k_sh, v_sh, att_sinks[j])
            else:
                a = swa_cached(q, k_sh, v_sh, k_buf, v_buf, att_sinks[j])
            y = a @ att_w_o[j]
        x = layer_norm(ALPHA * x + mods[:, 5, None, :] * y, ln_g[layer, 1], ln_b[layer, 1])
        f2 = swiglu(modulate(x, mods[:, 6], mods[:, 7]), ffn2_up[layer], ffn2_down[layer])
        x = layer_norm(ALPHA * x + 0.5 * mods[:, 8, None, :] * f2, ln_g[layer, 2], ln_b[layer, 2])
        if layer == N_A_LAYERS - 1:
            k_sh, v_sh = shared_kv(x, c_act, kv_ada_w, kv_ada_b, kv_w, pos)
    if is_prompt:
        keep = min(WINDOW, S)
        win_k = k_sh[:, S - keep:]
        win_v = v_sh[:, S - keep:]
    else:
        keep = k_buf.shape[1]
        win_k = jnp.concatenate([k_buf.astype(k_sh.dtype), k_sh], axis=1)[:, -keep:]
        win_v = jnp.concatenate([v_buf.astype(v_sh.dtype), v_sh], axis=1)[:, -keep:]
    return x, jnp.stack(Cs), jnp.stack(ns), jnp.stack(ms), win_k, win_v


def setup_inputs(seed: int = 0) -> dict:
    key = jax.random.key(seed)
    keys = iter(jax.random.split(key, 48))

    def nrm(shape, scale=1.0):
        return jax.random.normal(next(keys), shape, F32) * scale

    D, F = D_MODEL, D_FF
    HQK = ML_HEADS * ML_DK
    HV = ML_HEADS * ML_DV
    KVW = ATT_KV_HEADS * ATT_HD
    win_buf = min(WINDOW, PAST_LEN)
    x_prompt = nrm((BATCH, SEQ, D))
    x_sample = nrm((DEC_BATCH, DEC_SEQ, D))
    c_prompt = nrm((BATCH, D))
    c_sample = nrm((DEC_BATCH, D))
    state_mlstm_C = nrm((N_A_LAYERS, DEC_BATCH, ML_HEADS, ML_DK, ML_DV), 0.1)
    state_mlstm_n = nrm((N_A_LAYERS, DEC_BATCH, ML_HEADS, ML_DK), 0.1)
    state_mlstm_m = nrm((N_A_LAYERS, DEC_BATCH, ML_HEADS))
    cache_win_k = nrm((DEC_BATCH, win_buf, ATT_KV_HEADS, ATT_HD))
    cache_win_v = nrm((DEC_BATCH, win_buf, ATT_KV_HEADS, ATT_HD))
    ada_w = nrm((DEPTH, D, N_MOD * D), 0.5 * D ** -0.5)
    ada_b = nrm((DEPTH, N_MOD * D), 0.02)
    ffn1_up = nrm((DEPTH, D, 2 * F), D ** -0.5)
    ffn1_down = nrm((DEPTH, F, D), BETA * F ** -0.5)
    ffn2_up = nrm((DEPTH, D, 2 * F), D ** -0.5)
    ffn2_down = nrm((DEPTH, F, D), BETA * F ** -0.5)
    ln_g = 1.0 + nrm((DEPTH, 3, D), 0.02)
    ln_b = nrm((DEPTH, 3, D), 0.02)
    ml_w_in = jnp.concatenate([
        nrm((N_A_LAYERS, D, 2 * HQK), D ** -0.5),
        nrm((N_A_LAYERS, D, HV), BETA * D ** -0.5),
        nrm((N_A_LAYERS, D, HV), D ** -0.5),
        nrm((N_A_LAYERS, D, 2 * ML_HEADS), 0.1 * D ** -0.5)], axis=-1)
    ml_b_gates = jnp.concatenate([
        nrm((N_A_LAYERS, ML_HEADS), 0.1),
        jnp.linspace(3.0, 6.0, ML_HEADS)[None, :] + nrm((N_A_LAYERS, ML_HEADS), 0.1)], axis=-1)
    ml_norm_w = 1.0 + nrm((N_A_LAYERS, HV), 0.02)
    ml_w_out = nrm((N_A_LAYERS, HV, D), BETA * HV ** -0.5)
    kv_ada_w = nrm((D, 2 * D), 0.5 * D ** -0.5)
    kv_ada_b = nrm((2 * D,), 0.02)
    kv_w = jnp.concatenate([nrm((D, KVW), D ** -0.5), nrm((D, KVW), BETA * D ** -0.5)], axis=-1)
    att_w_q = nrm((N_B_LAYERS, D, ATT_Q_HEADS * ATT_HD), D ** -0.5)
    att_sinks = nrm((N_B_LAYERS, ATT_Q_HEADS), 0.5)
    att_w_o = nrm((N_B_LAYERS, ATT_Q_HEADS * ATT_HD, D), BETA * (ATT_Q_HEADS * ATT_HD) ** -0.5)
    return {'x_prompt': x_prompt, 'x_sample': x_sample, 'c_prompt': c_prompt, 'c_sample': c_sample,
            'state_mlstm_C': state_mlstm_C, 'state_mlstm_n': state_mlstm_n, 'state_mlstm_m': state_mlstm_m,
            'cache_win_k': cache_win_k, 'cache_win_v': cache_win_v,
            'ada_w': ada_w, 'ada_b': ada_b, 'ffn1_up': ffn1_up, 'ffn1_down': ffn1_down,
            'ffn2_up': ffn2_up, 'ffn2_down': ffn2_down, 'ln_g': ln_g, 'ln_b': ln_b,
            'ml_w_in': ml_w_in, 'ml_b_gates': ml_b_gates, 'ml_norm_w': ml_norm_w, 'ml_w_out': ml_w_out,
            'kv_ada_w': kv_ada_w, 'kv_ada_b': kv_ada_b, 'kv_w': kv_w,
            'att_w_q': att_w_q, 'att_sinks': att_sinks, 'att_w_o': att_w_o}


def reference(x_prompt, x_sample, c_prompt, c_sample, state_mlstm_C, state_mlstm_n, state_mlstm_m,
              cache_win_k, cache_win_v, ada_w, ada_b, ffn1_up, ffn1_down, ffn2_up, ffn2_down, ln_g, ln_b,
              ml_w_in, ml_b_gates, ml_norm_w, ml_w_out, kv_ada_w, kv_ada_b, kv_w,
              att_w_q, att_sinks, att_w_o):
    B = x_prompt.shape[0]
    C0 = jnp.zeros((N_A_LAYERS, B, ML_HEADS, ML_DK, ML_DV), F32)
    n0 = jnp.zeros((N_A_LAYERS, B, ML_HEADS, ML_DK), F32)
    m0 = jnp.zeros((N_A_LAYERS, B, ML_HEADS), F32)
    y_prompt, C_p, n_p, m_p, wk_p, wv_p = trunk(
        x_prompt, c_prompt, True, C0, n0, m0, None, None, ada_w, ada_b, ffn1_up, ffn1_down, ffn2_up, ffn2_down,
        ln_g, ln_b, ml_w_in, ml_b_gates, ml_norm_w, ml_w_out, kv_ada_w, kv_ada_b, kv_w, att_w_q, att_sinks, att_w_o)
    y_sample, C_s, n_s, m_s, wk_s, wv_s = trunk(
        x_sample, c_sample, False, state_mlstm_C, state_mlstm_n, state_mlstm_m, cache_win_k, cache_win_v,
        ada_w, ada_b, ffn1_up, ffn1_down, ffn2_up, ffn2_down, ln_g, ln_b, ml_w_in, ml_b_gates, ml_norm_w,
        ml_w_out, kv_ada_w, kv_ada_b, kv_w, att_w_q, att_sinks, att_w_o)
    return (y_prompt, y_sample, C_p, n_p, m_p, wk_p, wv_p, C_s, n_s, m_s, wk_s, wv_s)
```

```cpp
#include <hip/hip_runtime.h>
#include <hip/hip_cooperative_groups.h>
#include <cstdio>
#include <cstdint>
#include <cmath>
#include <cstring>
namespace cg = cooperative_groups;

typedef unsigned short bf16;
typedef __attribute__((ext_vector_type(8))) short bf16x8;
typedef __attribute__((ext_vector_type(4))) float f32x4;
typedef __attribute__((ext_vector_type(4))) unsigned u32x4;

constexpr int D = 1024, T = 16896, TP = 16384, SEQ = 8192, F = 2816;
constexpr int NBR = 130;
constexpr int MODW = 20480;
constexpr float ALPHA = 1.4142135623730951f;
constexpr float LN_EPS = 1e-5f;
#ifndef PROBE_REP
#define PROBE_REP 1
#define PROBE_MASK 0
#endif
#ifndef PROBE_SYNC2
#define PROBE_SYNC2 0
#endif
constexpr int NTHR = 512;
constexpr int LDS_BYTES = 131072;
constexpr int VLDS = 32768;

constexpr size_t O_Y = 0;
constexpr size_t O_CP = 17301504;
constexpr size_t O_NP = 17563648;
constexpr size_t O_MP = 17564672;
constexpr size_t O_WKP = 17564680;
constexpr size_t O_WVP = 17630216;
constexpr size_t O_CS = 17695752;
constexpr size_t O_NS = 34472968;
constexpr size_t O_MS = 34538504;
constexpr size_t O_WKS = 34539016;
constexpr size_t O_WVS = 38733320;

struct Params;
struct WDesc { const float* src; bf16* dst; int K, N, ld, tstart, mode, pad; };

struct Params {
  const float* in[27];
  float* out;
  WDesc wd[20];
  int wd_total; int pad0;
  bf16 *wt_ada, *wt_up[4], *wt_down[4], *wt_mlin, *wt_mlout, *wt_kv, *wt_q, *wt_o;
  bf16* cact; float* mods; float2* rot; bf16* H; float* gates;
  bf16 *hid, *proj, *kt, *vt, *uck, *vsamp;
  float *un, *ab, *nk, *mk;
  bf16 *hkv, *ks, *vta, *q, *att;
  int* dbg; float* stash; unsigned* bar; float* part;
  double inv_freq[8];
};

typedef const __attribute__((address_space(4))) Params& PRef;

enum { I_XP = 0, I_XS, I_CP, I_CS, I_STC, I_STN, I_STM, I_CK, I_CV, I_ADAW, I_ADAB, I_F1U, I_F1D, I_F2U, I_F2D, I_LNG, I_LNB,
       I_MLWIN, I_MLBG, I_MLNW, I_MLWOUT, I_KVADAW, I_KVADAB, I_KVW, I_ATTWQ, I_SINKS, I_ATTWO };

__device__ __forceinline__ bf16 f2bf(float f) {
  unsigned u = __float_as_uint(f);
  u += 0x7fffu + ((u >> 16) & 1u);
  return (bf16)(u >> 16);
}
__device__ __forceinline__ float bf2f(bf16 h) { return __uint_as_float(((unsigned)h) << 16); }
__device__ __forceinline__ unsigned pack2(float a, float b) { return (unsigned)f2bf(a) | ((unsigned)f2bf(b) << 16); }
__device__ __forceinline__ int brow_of(int tok) { return tok < TP ? (tok >> 13) : 2 + ((tok - TP) >> 2); }
__device__ __forceinline__ int pos_of(int tok) { return tok < TP ? (tok & 8191) : 8192 + ((tok - TP) & 3); }
__device__ __forceinline__ float wave_sum(float v) {
#pragma unroll
  for (int o = 32; o > 0; o >>= 1) v += __shfl_xor(v, o);
  return v;
}
__device__ __forceinline__ float wave_max(float v) {
#pragma unroll
  for (int o = 32; o > 0; o >>= 1) v = fmaxf(v, __shfl_xor(v, o));
  return v;
}
__device__ __forceinline__ float scan_add(float x, int lane) {
#pragma unroll
  for (int o = 1; o < 64; o <<= 1) { float y = __shfl_up(x, o); if (lane >= o) x += y; }
  return x;
}
__device__ __forceinline__ float scan_max(float x, int lane) {
#pragma unroll
  for (int o = 1; o < 64; o <<= 1) { float y = __shfl_up(x, o); if (lane >= o) x = fmaxf(x, y); }
  return x;
}
__device__ __forceinline__ float sigmoidf_(float x) { return 1.f / (1.f + __expf(-x)); }
__device__ __forceinline__ int opq_tid() { int t = threadIdx.x; asm volatile("" : "+v"(t)); return t; }
__device__ __forceinline__ int opq_bid() { int t = blockIdx.x; asm volatile("" : "+s"(t)); return t; }
__device__ __forceinline__ int opq_gdim() { int t = gridDim.x; asm volatile("" : "+s"(t)); return t; }
__device__ __forceinline__ int vq_tid() { return opq_tid() & 255; }
__device__ __forceinline__ int vq_vb() { return __builtin_amdgcn_readfirstlane(opq_tid() >> 8); }
__device__ __forceinline__ int vq_bid() { return opq_bid() * 2 + vq_vb(); }
__device__ __forceinline__ int vq_gdim() { return opq_gdim() * 2; }
__device__ __forceinline__ float4 ldnt4(const float* q) { const f32x4 v = __builtin_nontemporal_load((const f32x4*)q); return make_float4(v[0], v[1], v[2], v[3]); }
#define MFMA(a, b, c) __builtin_amdgcn_mfma_f32_16x16x32_bf16(a, b, c, 0, 0, 0)

struct WInfo { const float* src; bf16* dst; int K, ld, mode, k0, n0; };
__device__ __forceinline__ WInfo prep_lookup(PRef p, int t) {
  WDesc w;
  w.src = p.wd[0].src; w.dst = p.wd[0].dst; w.K = p.wd[0].K; w.N = p.wd[0].N; w.ld = p.wd[0].ld; w.tstart = p.wd[0].tstart; w.mode = p.wd[0].mode;
#pragma unroll
  for (int i = 1; i < 20; ++i) if (t >= p.wd[i].tstart) { w.src = p.wd[i].src; w.dst = p.wd[i].dst; w.K = p.wd[i].K; w.N = p.wd[i].N; w.ld = p.wd[i].ld; w.tstart = p.wd[i].tstart; w.mode = p.wd[i].mode; }
  const int lt = t - w.tstart, nnt = w.N >> 6;
  WInfo r; r.src = w.src; r.dst = w.dst; r.K = w.K; r.ld = w.ld; r.mode = w.mode; r.n0 = (lt % nnt) * 64; r.k0 = (lt / nnt) * 64;
  return r;
}
__device__ __forceinline__ void phase_prep(PRef p, char* smem, int part) {
  const int tid = vq_tid();
  float* tile = (float*)(smem + vq_vb() * VLDS);
  const int vbid = vq_bid(), vg = vq_gdim(), total = p.wd_total;
  const int kr = tid >> 4, nc = (tid & 15) * 4;
#define PREP_LOAD(R, W, ACT) do { if (ACT) { const float* sp = (W).src + (size_t)((W).k0 + kr) * (W).ld + (W).n0 + nc; \
    (R##0) = ldnt4(sp); (R##1) = ldnt4(sp + (size_t)16 * (W).ld); (R##2) = ldnt4(sp + (size_t)32 * (W).ld); (R##3) = ldnt4(sp + (size_t)48 * (W).ld); } } while (0)
#define PREP_TOLDS(R, ACT) do { if (ACT) { float* tp = tile + kr * 65 + nc; \
    tp[0] = (R##0).x; tp[1] = (R##0).y; tp[2] = (R##0).z; tp[3] = (R##0).w; \
    tp[16 * 65 + 0] = (R##1).x; tp[16 * 65 + 1] = (R##1).y; tp[16 * 65 + 2] = (R##1).z; tp[16 * 65 + 3] = (R##1).w; \
    tp[32 * 65 + 0] = (R##2).x; tp[32 * 65 + 1] = (R##2).y; tp[32 * 65 + 2] = (R##2).z; tp[32 * 65 + 3] = (R##2).w; \
    tp[48 * 65 + 0] = (R##3).x; tp[48 * 65 + 1] = (R##3).y; tp[48 * 65 + 2] = (R##3).z; tp[48 * 65 + 3] = (R##3).w; } } while (0)
#define PREP_STORE(W, ACT) do { if (ACT) { _Pragma("unroll") for (int i = 0; i < 2; ++i) { \
      int id = tid + i * 256; int n = id >> 3, kc = (id & 7) * 8; uint4 o; \
      o.x = pack2(tile[(kc + 0) * 65 + n], tile[(kc + 1) * 65 + n]); o.y = pack2(tile[(kc + 2) * 65 + n], tile[(kc + 3) * 65 + n]); \
      o.z = pack2(tile[(kc + 4) * 65 + n], tile[(kc + 5) * 65 + n]); o.w = pack2(tile[(kc + 6) * 65 + n], tile[(kc + 7) * 65 + n]); \
      int gn = (W).n0 + n; \
      if ((W).mode & 1) { const int isu = gn >= F; const int j = isu ? gn - F : gn; gn = (j >> 7) * 256 + ((j >> 2) & 1) * 128 + ((j >> 5) & 3) * 32 + isu * 16 + ((j >> 3) & 3) * 4 + (j & 3); } \
      if ((W).mode & 2) __builtin_nontemporal_store((u32x4){o.x, o.y, o.z, o.w}, (u32x4*)((W).dst + (size_t)gn * (W).K + (W).k0 + kc)); \
      else *(uint4*)((W).dst + (size_t)gn * (W).K + (W).k0 + kc) = o; } } } while (0)
  float4 ra0, ra1, ra2, ra3, rb0, rb1, rb2, rb3;
  ra0 = ra1 = ra2 = ra3 = rb0 = rb1 = rb2 = rb3 = make_float4(0.f, 0.f, 0.f, 0.f);
  const int nA = p.wd[3].tstart, nB = total - nA;
  constexpr int HEAD = 10, ADA_VB = 160;
  const int nn = vg - ADA_VB;
  const bool weighted = (part == 1) && nn > 0 && HEAD * nn <= nB;
  const int headTiles = weighted ? HEAD * nn : 0;
  const int iters = part == 0 ? (nA + vg - 1) / vg : (weighted ? HEAD : 0) + (nB - headTiles + vg - 1) / vg;
  auto seq = [&](int idx) -> int {
    if (part == 0) { const int t = vbid + idx * vg; return t < nA ? t : -1; }
    int t;
    if (weighted && vbid >= ADA_VB) t = idx < HEAD ? (vbid - ADA_VB) + idx * nn : headTiles + vbid + (idx - HEAD) * vg;
    else t = headTiles + vbid + idx * vg;
    return t < nB ? nA + t : -1;
  };
  int ta = seq(0), tb = seq(1);
  bool acta = ta >= 0, actb = tb >= 0;
  WInfo wa = prep_lookup(p, acta ? ta : 0), wb = prep_lookup(p, actb ? tb : 0);
  PREP_LOAD(ra, wa, acta);
  PREP_LOAD(rb, wb, actb);
  for (int k = 0; 2 * k < iters; ++k) {
    PREP_TOLDS(ra, acta);
    __syncthreads();
    const WInfo wa_cur = wa; const bool acta_cur = acta;
    ta = seq(2 * k + 2); acta = ta >= 0; wa = prep_lookup(p, acta ? ta : 0);
    PREP_LOAD(ra, wa, acta);
    PREP_STORE(wa_cur, acta_cur);
    __syncthreads();
    PREP_TOLDS(rb, actb);
    __syncthreads();
    const WInfo wb_cur = wb; const bool actb_cur = actb;
    tb = seq(2 * k + 3); actb = tb >= 0; wb = prep_lookup(p, actb ? tb : 0);
    PREP_LOAD(rb, wb, actb);
    PREP_STORE(wb_cur, actb_cur);
    __syncthreads();
  }
#undef PREP_LOAD
#undef PREP_TOLDS
#undef PREP_STORE
  if (part != 0) return;
  const int gt = opq_bid() * NTHR + opq_tid(), gs = opq_gdim() * NTHR;
  for (int i = gt; i < 256 * 1024; i += gs) {
    int r = i >> 10, c = i & 1023;
    float v = 0.f;
    if (r < 2) v = p.in[I_CP][r * 1024 + c]; else if (r < NBR) v = p.in[I_CS][(r - 2) * 1024 + c];
    v = v / (1.f + expf(-v));
    p.cact[i] = (r < NBR) ? f2bf(v) : (bf16)0;
  }
  for (int i = gt; i < 8196 * 8; i += gs) {
    int pos = i >> 3, fi = i & 7;
    double ang = (double)pos * p.inv_freq[fi];
    const double TWO_PI_HI = 6.283185307179586232, TWO_PI_LO = 2.449293598294706414e-16;
    double k = rint(ang * 0.15915494309189533577);
    double r = fma(-k, TWO_PI_HI, ang); r = fma(-k, TWO_PI_LO, r);
    double r2 = r * r;
    double s = 1.0, c = 1.0;
#pragma unroll 1
    for (int n = 14; n >= 1; --n) {
      s = 1.0 - s * r2 / (double)((2 * n) * (2 * n + 1));
      c = 1.0 - c * r2 / (double)((2 * n - 1) * (2 * n));
    }
    s *= r;
    p.rot[i] = make_float2((float)c, (float)s);
  }
}

enum { M_ADA = 0, M_SWIGLU, M_RES, M_MLIN, M_KV, M_Q, M_PART };
struct GArgs { const bf16* A; int lda; const bf16* Bt; int K; int M, N; int goff; float wgt; float alpha; int ldb, uG, ucid; const float* xsrc; };
#define LAS __attribute__((address_space(3)))
constexpr int G_BM = 256, G_BK = 64, G_HALF = 128, G_HTB = G_HALF * G_BK * 2;
__device__ __forceinline__ int lds_byte(int r, int c) { const int st = (r >> 4) * 2 + (c >> 5), rr = r & 15, cc = c & 31, ob = rr * 64 + cc * 2; return st * 1024 + (ob ^ (((ob >> 9) & 1) << 5)); }
__device__ __forceinline__ void stage_rc(int b, int& R, int& C) { const int st = b / 1024, sb = b % 1024, swz = sb ^ (((sb >> 9) & 1) << 5); R = (st >> 1) * 16 + swz / 64; C = (st & 1) * 32 + (swz % 64) / 2; }
__device__ __forceinline__ bool unit_next(int i, int G, int c, int nM, int nN, int& pm, int& pn) {
  const int nwg = nM * nN;
  const long L = (long)i * G + c; if (L >= nwg) return false;
  int wgid = (int)L; { const int q = nwg / 8, r = nwg % 8, xcd = wgid % 8, off = wgid / 8; wgid = (xcd < r ? xcd * (q + 1) : r * (q + 1) + (xcd - r) * q) + off; }
  const int nig = 8 * nN, gid = wgid / nig, fm = gid * 8, gsz = (nM - fm) < 8 ? (nM - fm) : 8;
  pm = fm + ((wgid % nig) % gsz); pn = (wgid % nig) / gsz; return true;
}

template <int MODE>
__device__ __forceinline__ void gemm_epilogue(PRef p, const GArgs& g, const f32x4 (&acc)[2][2][4][2], int pm, int pn, int wr, int wc, int fr, int fq) {
#pragma unroll
  for (int ai = 0; ai < 2; ++ai)
#pragma unroll
    for (int m = 0; m < 4; ++m) {
      const int row = pm * 256 + ai * 128 + wr * 64 + m * 16 + fr;
#pragma unroll
      for (int bj = 0; bj < 2; ++bj) {
        const int cb = pn * 256 + bj * 128 + wc * 32 + 4 * fq;
        if constexpr (MODE == M_PART) {
#pragma unroll
          for (int n = 0; n < 2; ++n)
            *(f32x4*)(p.part + ((size_t)g.goff * 512 + row) * g.N + cb + n * 16) = acc[ai][bj][m][n];
        } else if constexpr (MODE == M_ADA) {
          if (row < NBR) {
#pragma unroll
            for (int n = 0; n < 2; ++n) {
              const int col = cb + n * 16;
              const f32x4 bias = col < 18432 ? *(const f32x4*)(p.in[I_ADAB] + col) : *(const f32x4*)(p.in[I_KVADAB] + (col - 18432));
              *(f32x4*)(p.mods + (size_t)row * MODW + col) = acc[ai][bj][m][n] + bias;
            }
          }
        } else if constexpr (MODE == M_SWIGLU) {
          if (bj == 0) {
            const int hc = pn * 128 + wc * 32 + 8 * fq;
            const f32x4 a0 = acc[ai][0][m][0], u0 = acc[ai][0][m][1], a1 = acc[ai][1][m][0], u1 = acc[ai][1][m][1];
            uint4 o;
            o.x = pack2(a0[0] * __builtin_amdgcn_rcpf(1.f + __expf(-a0[0])) * u0[0], a0[1] * __builtin_amdgcn_rcpf(1.f + __expf(-a0[1])) * u0[1]);
            o.y = pack2(a0[2] * __builtin_amdgcn_rcpf(1.f + __expf(-a0[2])) * u0[2], a0[3] * __builtin_amdgcn_rcpf(1.f + __expf(-a0[3])) * u0[3]);
            o.z = pack2(a1[0] * __builtin_amdgcn_rcpf(1.f + __expf(-a1[0])) * u1[0], a1[1] * __builtin_amdgcn_rcpf(1.f + __expf(-a1[1])) * u1[1]);
            o.w = pack2(a1[2] * __builtin_amdgcn_rcpf(1.f + __expf(-a1[2])) * u1[2], a1[3] * __builtin_amdgcn_rcpf(1.f + __expf(-a1[3])) * u1[3]);
            *(uint4*)(p.hid + (size_t)row * F + hc) = o;
          }
        } else if constexpr (MODE == M_RES) {
          const float* __restrict__ gm = p.mods + (size_t)brow_of(row) * MODW + g.goff;
          float* __restrict__ Xr = p.out;
          const float* xs = g.xsrc;
#pragma unroll
          for (int n = 0; n < 2; ++n) {
            const int col = cb + n * 16;
            f32x4* xp = (f32x4*)(Xr + (size_t)row * D + col);
            const f32x4 gv = *(const f32x4*)(gm + col);
            const f32x4 xin = (xs != (const float*)Xr) ? __builtin_nontemporal_load((const f32x4*)(xs + (size_t)row * D + col)) : *(const f32x4*)(xs + (size_t)row * D + col);
            *xp = g.alpha * xin + g.wgt * gv * acc[ai][bj][m][n];
          }
        } else if constexpr (MODE == M_MLIN) {
          const bool prompt = pm < 64;
          const int b = row >> 13, sq = row & 8191;
#pragma unroll
          for (int n = 0; n < 2; ++n) {
            const int col = cb + n * 16;
            f32x4 v = acc[ai][bj][m][n];
            if (pn < 2) {
              uint2 o; o.x = pack2(v[0], v[1]); o.y = pack2(v[2], v[3]);
              *(uint2*)(p.proj + (size_t)row * 2048 + col) = o;
            } else if (pn < 4) {
              v = v * 0.08838834764831845f;
              uint2 o; o.x = pack2(v[0], v[1]); o.y = pack2(v[2], v[3]);
              *(uint2*)(p.proj + (size_t)row * 2048 + col) = o;
              if (prompt) {
                const int c2 = col - 512, h = c2 >> 7, dk = c2 & 127;
                bf16* kp = p.kt + ((size_t)((b * 4 + h) * 128 + dk)) * SEQ + sq;
                kp[0] = f2bf(v[0]); kp[SEQ] = f2bf(v[1]); kp[2 * SEQ] = f2bf(v[2]); kp[3 * SEQ] = f2bf(v[3]);
              }
            } else if (pn < 8) {
              uint2 o; o.x = pack2(v[0], v[1]); o.y = pack2(v[2], v[3]);
              *(uint2*)(p.proj + (size_t)row * 2048 + (col - 1024) + 1024) = o;
            } else {
              const int c2 = col - 2048;
              if (prompt) {
                const int h = c2 >> 8, dv = c2 & 255;
                bf16* vp = p.vt + ((size_t)((b * 4 + h) * 256 + dv)) * SEQ + sq;
                vp[0] = f2bf(v[0]); vp[SEQ] = f2bf(v[1]); vp[2 * SEQ] = f2bf(v[2]); vp[3 * SEQ] = f2bf(v[3]);
              } else {
                uint2 o; o.x = pack2(v[0], v[1]); o.y = pack2(v[2], v[3]);
                *(uint2*)(p.vsamp + (size_t)(row - TP) * 1024 + c2) = o;
              }
            }
          }
        } else if constexpr (MODE == M_KV || MODE == M_Q) {
          const bool prompt = pm < 64;
#pragma unroll
          for (int n = 0; n < 2; ++n) {
            const int col = cb + n * 16;
            f32x4 v = acc[ai][bj][m][n];
            const bool rot = (MODE == M_Q || pn == 0) && n == 0 && (wc & 1) == 0;
            if (rot) {
              const int pos = pos_of(row);
#pragma unroll
              for (int j = 0; j < 4; ++j) {
                const float partner = __shfl_xor(v[j], 32);
                const float2 cs = p.rot[pos * 8 + ((4 * fq + j) & 7)];
                v[j] = (fq < 2) ? (v[j] * cs.x - partner * cs.y) : (v[j] * cs.x + partner * cs.y);
              }
            }
            if constexpr (MODE == M_Q) {
              v = v * 0.125f;
              uint2 o; o.x = pack2(v[0], v[1]); o.y = pack2(v[2], v[3]);
              *(uint2*)(p.q + (size_t)row * D + col) = o;
            } else {
              const bool isk = pn == 0;
              const int cc = col & 255, kvh = cc >> 6, d = cc & 63;
              if (isk) {
                uint2 o; o.x = pack2(v[0], v[1]); o.y = pack2(v[2], v[3]);
                *(uint2*)(p.ks + (size_t)row * 256 + cc) = o;
              } else if (prompt) {
                bf16* vp = p.vta + ((size_t)(((row >> 13) * 4 + kvh) * 64 + d)) * SEQ + (row & 8191);
                vp[0] = f2bf(v[0]); vp[SEQ] = f2bf(v[1]); vp[2 * SEQ] = f2bf(v[2]); vp[3 * SEQ] = f2bf(v[3]);
              }
              float* wout = p.out + (isk ? (prompt ? O_WKP : O_WKS) : (prompt ? O_WVP : O_WVS));
              if (prompt) {
                const int bb = row >> 13, sq = row & 8191;
                if (sq >= SEQ - 128) *(f32x4*)(wout + ((size_t)(bb * 128 + (sq - (SEQ - 128))) * 4 + kvh) * 64 + d) = v;
              } else {
                const int bb = (row - TP) >> 2, t = (row - TP) & 3;
                *(f32x4*)(wout + ((size_t)(bb * 128 + 124 + t) * 4 + kvh) * 64 + d) = v;
              }
            }
          }
        }
      }
    }
}

template <int MODE>
__device__ __forceinline__ void gemm_phase(PRef p, const GArgs& g, char* smem) {
  LAS unsigned char* lds = (LAS unsigned char*)smem;
  const int tid = opq_tid(), wid = __builtin_amdgcn_readfirstlane(tid >> 6), lane = tid & 63, wr = wid >> 2, wc = wid & 3, fr = lane & 15, fq = lane >> 4;
  const int K = g.K, nt = K / G_BK, lda = g.lda, ldb = g.ldb;
  const int nM = g.M / G_BM, nN = g.N / G_BM, G = g.uG ? g.uG : opq_gdim(), cid = g.uG ? g.ucid : opq_bid();
  unsigned voffA[2], voffB[2];
#pragma unroll
  for (int i = 0; i < 2; ++i) { int R, C; stage_rc(tid * 16 + i * 8192, R, C); voffA[i] = (unsigned)(R * lda + C) * 2u; voffB[i] = (unsigned)(R * ldb + C) * 2u; }
  const size_t kstep = (size_t)(G_BK * 2);
  const size_t hstepA = (size_t)G_HALF * lda * 2, hstepB = (size_t)G_HALF * ldb * 2;
  const size_t tstepA = 2 * hstepA, tstepB = 2 * hstepB;
  const unsigned ldsw = (unsigned)wid * 1024u;
  const int aoff = lds_byte(wr * 64 + fr, fq * 8), boff = lds_byte(wc * 32 + fr, fq * 8);
#define PG8_SA(b, h) (((b) * 2 + (h)) * G_HTB)
#define PG8_SB(b, h) ((4 + (b) * 2 + (h)) * G_HTB)
#define PG8_STAGE(bufoff, gbase, voff) do { _Pragma("unroll") for (int _i = 0; _i < 2; ++_i) \
        __builtin_amdgcn_global_load_lds((const unsigned*)((const char*)(gbase) + (voff)[_i]), (LAS unsigned*)(lds + (bufoff) + ldsw + _i * 8192), 16, 0, 0); } while (0)
#define PG8_LDA(dst, b, h) do { _Pragma("unroll") for (int m = 0; m < 4; ++m) _Pragma("unroll") for (int k = 0; k < 2; ++k) dst[m][k] = *(const LAS bf16x8*)(lds + PG8_SA(b, h) + aoff + m * 2048 + k * 1024); } while (0)
#define PG8_LDB(dst, b, h) do { _Pragma("unroll") for (int n = 0; n < 2; ++n) _Pragma("unroll") for (int k = 0; k < 2; ++k) dst[n][k] = *(const LAS bf16x8*)(lds + PG8_SB(b, h) + boff + n * 2048 + k * 1024); } while (0)
#define PG8_MMA(ai, bj, At, Bt) do { __builtin_amdgcn_s_setprio(1); _Pragma("unroll") for (int m = 0; m < 4; ++m) _Pragma("unroll") for (int n = 0; n < 2; ++n) _Pragma("unroll") for (int k = 0; k < 2; ++k) \
        acc[ai][bj][m][n] = __builtin_amdgcn_mfma_f32_16x16x32_bf16(Bt[n][k], At[m][k], acc[ai][bj][m][n], 0, 0, 0); __builtin_amdgcn_s_setprio(0); } while (0)
#define PG8_WAIT_V(n) asm volatile("s_waitcnt vmcnt(" #n ")" ::: "memory")
#define PG8_WAIT_L(n) asm volatile("s_waitcnt lgkmcnt(" #n ")" ::: "memory")
#define PG8_BAR __builtin_amdgcn_s_barrier()
#define PG8_SCHED __builtin_amdgcn_sched_barrier(0)
  int cpm, cpn, npm = 0, npn = 0, ui = 0;
  if (unit_next(0, G, cid, nM, nN, cpm, cpn)) {
    f32x4 acc[2][2][4][2];
#pragma unroll
    for (int a = 0; a < 2; ++a)
#pragma unroll
      for (int b = 0; b < 2; ++b)
#pragma unroll
        for (int m = 0; m < 4; ++m)
#pragma unroll
          for (int n = 0; n < 2; ++n) acc[a][b][m][n] = (f32x4){0.f, 0.f, 0.f, 0.f};
    bf16x8 At[4][2], B0[2][2], B1[2][2];
    const char* cA = (const char*)g.A + (size_t)cpm * tstepA; const char* cB = (const char*)g.Bt + (size_t)cpn * tstepB;
    PG8_STAGE(PG8_SB(0, 0), cB, voffB); PG8_STAGE(PG8_SB(0, 1), cB + hstepB, voffB); PG8_STAGE(PG8_SA(0, 0), cA, voffA); PG8_STAGE(PG8_SA(0, 1), cA + hstepA, voffA);
    if (wr == 1) PG8_BAR;
    PG8_WAIT_V(2); PG8_BAR;
    PG8_STAGE(PG8_SB(1, 0), cB + kstep, voffB); PG8_STAGE(PG8_SA(1, 0), cA + kstep, voffA); PG8_STAGE(PG8_SB(1, 1), cB + hstepB + kstep, voffB);
    PG8_WAIT_V(6); PG8_BAR;
    for (;;) {
      const bool has_next = unit_next(ui + 1, G, cid, nM, nN, npm, npn);
      const char* nA = has_next ? (const char*)g.A + (size_t)npm * tstepA : cA; const char* nB = has_next ? (const char*)g.Bt + (size_t)npn * tstepB : cB;
      for (int t = 0; t < nt; t += 2) {
        const bool last = (t == nt - 2);
        const char* a1 = cA + (size_t)(t + 1) * kstep;
        const char* a2 = last ? nA : cA + (size_t)(t + 2) * kstep; const char* b2 = last ? nB : cB + (size_t)(t + 2) * kstep;
        const char* a3 = a2 + kstep; const char* b3 = b2 + kstep;
        PG8_LDB(B0, 0, 0); PG8_LDB(B1, 0, 1); PG8_SCHED; PG8_LDA(At, 0, 0); PG8_STAGE(PG8_SA(1, 1), a1 + hstepA, voffA);
        PG8_WAIT_V(8); PG8_WAIT_L(0); PG8_BAR; PG8_MMA(0, 0, At, B0); PG8_MMA(0, 1, At, B1); PG8_BAR; PG8_SCHED;
        PG8_LDA(At, 0, 1); PG8_STAGE(PG8_SB(0, 0), b2, voffB); PG8_STAGE(PG8_SB(0, 1), b2 + hstepB, voffB); PG8_STAGE(PG8_SA(0, 0), a2, voffA);
        PG8_WAIT_V(8); PG8_WAIT_L(0); PG8_BAR; PG8_MMA(1, 0, At, B0); PG8_MMA(1, 1, At, B1); PG8_BAR; PG8_SCHED;
        PG8_LDB(B0, 1, 0); PG8_LDB(B1, 1, 1); PG8_SCHED; PG8_LDA(At, 1, 0); PG8_STAGE(PG8_SA(0, 1), a2 + hstepA, voffA);
        PG8_WAIT_V(8); PG8_WAIT_L(0); PG8_BAR; PG8_MMA(0, 0, At, B0); PG8_MMA(0, 1, At, B1); PG8_BAR; PG8_SCHED;
        PG8_LDA(At, 1, 1); PG8_STAGE(PG8_SB(1, 0), b3, voffB); PG8_STAGE(PG8_SB(1, 1), b3 + hstepB, voffB); PG8_STAGE(PG8_SA(1, 0), a3, voffA);
        PG8_WAIT_V(8); PG8_WAIT_L(0); PG8_BAR; PG8_MMA(1, 0, At, B0); PG8_MMA(1, 1, At, B1); PG8_BAR; PG8_SCHED;
      }
      if (wr == 0) PG8_BAR;
      gemm_epilogue<MODE>(p, g, acc, cpm, cpn, wr, wc, fr, fq);
      if (!has_next) break;
#pragma unroll
      for (int a = 0; a < 2; ++a)
#pragma unroll
        for (int b = 0; b < 2; ++b)
#pragma unroll
          for (int m = 0; m < 4; ++m)
#pragma unroll
            for (int n = 0; n < 2; ++n) acc[a][b][m][n] = (f32x4){0.f, 0.f, 0.f, 0.f};
      cpm = npm; cpn = npn; cA = nA; cB = nB; ++ui;
      if (wr == 1) PG8_BAR;
    }
    PG8_WAIT_V(0);
    PG8_BAR;
  }
#undef PG8_SA
#undef PG8_SB
#undef PG8_STAGE
#undef PG8_LDA
#undef PG8_LDB
#undef PG8_MMA
#undef PG8_WAIT_V
#undef PG8_WAIT_L
#undef PG8_BAR
#undef PG8_SCHED
}

struct LnArgs {
  int src_input;
  int layer, j;
  int hoff;
  int kvoff;
  int gates;
  int nsl;
  int pgoff; float pwgt;
  int xfirst;
};

__device__ __forceinline__ void ln_phase(PRef p, const LnArgs a, char* smem) {
  const int tid = opq_tid(), lane = tid & 63, wave = __builtin_amdgcn_readfirstlane(tid >> 6);
  float* wg = (float*)smem;
  if (a.gates) {
    for (int i = tid; i < 8192; i += NTHR) {
      int k = i >> 3, gi = i & 7;
      wg[gi * 1024 + k] = p.in[I_MLWIN][(size_t)k * 3080 + 3072 + gi];
    }
    __syncthreads();
  }
  float* __restrict__ X = p.out;
  const float* __restrict__ lg = p.in[I_LNG] + (a.layer * 3 + a.j) * D;
  const float* __restrict__ lb = p.in[I_LNB] + (a.layer * 3 + a.j) * D;
  const float* __restrict__ modsr = p.mods;
  const float* __restrict__ partr = p.part;
  for (int row = opq_bid() * 8 + wave; row < T; row += opq_gdim() * 8) {
    float4 v[4];
    if (a.src_input == 2) {
#pragma unroll
      for (int i = 0; i < 4; ++i) v[i] = *(const float4*)(X + (size_t)row * D + i * 256 + lane * 4);
    } else if (a.src_input) {
      const float* src = row < TP ? p.in[I_XP] + (size_t)row * D : p.in[I_XS] + (size_t)(row - TP) * D;
#pragma unroll
      for (int i = 0; i < 4; ++i) v[i] = ldnt4(src + i * 256 + lane * 4);
    } else {
      if (a.xfirst && row >= TP) {
#pragma unroll
        for (int i = 0; i < 4; ++i) v[i] = *(const float4*)(p.in[I_XS] + (size_t)(row - TP) * D + i * 256 + lane * 4);
      } else {
#pragma unroll
        for (int i = 0; i < 4; ++i) v[i] = ldnt4(X + (size_t)row * D + i * 256 + lane * 4);
      }
      if (a.nsl > 0 && row >= TP) {
        const float* __restrict__ gmr = modsr + (size_t)brow_of(row) * MODW + a.pgoff;
#pragma unroll
        for (int i = 0; i < 4; ++i) {
          float4 ps = make_float4(0.f, 0.f, 0.f, 0.f);
          for (int sl = 0; sl < a.nsl; ++sl) {
            const float4 t4 = *(const float4*)(partr + ((size_t)sl * 512 + (row - TP)) * 1024 + i * 256 + lane * 4);
            ps.x += t4.x; ps.y += t4.y; ps.z += t4.z; ps.w += t4.w;
          }
          const float4 gg = *(const float4*)(gmr + i * 256 + lane * 4);
          v[i].x = ALPHA * v[i].x + a.pwgt * gg.x * ps.x; v[i].y = ALPHA * v[i].y + a.pwgt * gg.y * ps.y;
          v[i].z = ALPHA * v[i].z + a.pwgt * gg.z * ps.z; v[i].w = ALPHA * v[i].w + a.pwgt * gg.w * ps.w;
        }
      }
      float s = 0.f;
#pragma unroll
      for (int i = 0; i < 4; ++i) s += (v[i].x + v[i].y) + (v[i].z + v[i].w);
      const float mu = wave_sum(s) * (1.f / 1024.f);
      float qv = 0.f;
#pragma unroll
      for (int i = 0; i < 4; ++i) {
        v[i].x -= mu; v[i].y -= mu; v[i].z -= mu; v[i].w -= mu;
        qv += v[i].x * v[i].x + v[i].y * v[i].y + v[i].z * v[i].z + v[i].w * v[i].w;
      }
      const float rstd = rsqrtf(wave_sum(qv) * (1.f / 1024.f) + LN_EPS);
#pragma unroll
      for (int i = 0; i < 4; ++i) {
        const float4 gg = *(const float4*)(lg + i * 256 + lane * 4);
        const float4 bb = *(const float4*)(lb + i * 256 + lane * 4);
        v[i].x = v[i].x * rstd * gg.x + bb.x; v[i].y = v[i].y * rstd * gg.y + bb.y;
        v[i].z = v[i].z * rstd * gg.z + bb.z; v[i].w = v[i].w * rstd * gg.w + bb.w;
      }
    }
    if (a.src_input != 1) {
#pragma unroll
      for (int i = 0; i < 4; ++i) {
        if (a.hoff < 0 && a.kvoff < 0) __builtin_nontemporal_store((f32x4){v[i].x, v[i].y, v[i].z, v[i].w}, (f32x4*)(X + (size_t)row * D + i * 256 + lane * 4));
        else *(float4*)(X + (size_t)row * D + i * 256 + lane * 4) = v[i];
      }
    }
    const float* __restrict__ mrow = modsr + (size_t)brow_of(row) * MODW;
    if (a.kvoff >= 0) {
#pragma unroll
      for (int i = 0; i < 4; ++i) {
        const float4 sh = *(const float4*)(mrow + a.kvoff + i * 256 + lane * 4);
        const float4 sc = *(const float4*)(mrow + a.kvoff + 1024 + i * 256 + lane * 4);
        uint2 o;
        o.x = pack2(v[i].x * (1.f + sc.x) + sh.x, v[i].y * (1.f + sc.y) + sh.y);
        o.y = pack2(v[i].z * (1.f + sc.z) + sh.z, v[i].w * (1.f + sc.w) + sh.w);
        *(uint2*)(p.hkv + (size_t)row * D + i * 256 + lane * 4) = o;
      }
    }
    if (a.hoff >= 0) {
      float gacc[8];
#pragma unroll
      for (int gi = 0; gi < 8; ++gi) gacc[gi] = 0.f;
#pragma unroll
      for (int i = 0; i < 4; ++i) {
        const float4 sh = *(const float4*)(mrow + a.hoff + i * 256 + lane * 4);
        const float4 sc = *(const float4*)(mrow + a.hoff + 1024 + i * 256 + lane * 4);
        float4 h;
        h.x = v[i].x * (1.f + sc.x) + sh.x; h.y = v[i].y * (1.f + sc.y) + sh.y;
        h.z = v[i].z * (1.f + sc.z) + sh.z; h.w = v[i].w * (1.f + sc.w) + sh.w;
        uint2 o; o.x = pack2(h.x, h.y); o.y = pack2(h.z, h.w);
        *(uint2*)(p.H + (size_t)row * D + i * 256 + lane * 4) = o;
        if (a.gates) {
#pragma unroll
          for (int gi = 0; gi < 8; ++gi) {
            const float4 w4 = *(const float4*)(wg + gi * 1024 + i * 256 + lane * 4);
            gacc[gi] += h.x * w4.x + h.y * w4.y + h.z * w4.z + h.w * w4.w;
          }
        }
      }
      if (a.gates) {
#pragma unroll
        for (int gi = 0; gi < 8; ++gi) gacc[gi] = wave_sum(gacc[gi]);
        if (lane == 0) {
#pragma unroll
          for (int gi = 0; gi < 8; ++gi) {
            float x = gacc[gi] + p.in[I_MLBG][gi];
            if (gi >= 4) x = (x >= 0.f) ? -log1pf(expf(-x)) : (x - log1pf(expf(x)));
            p.gates[(size_t)row * 8 + gi] = x;
          }
        }
      }
    }
  }
}

__device__ __forceinline__ void mlstm_A_item(PRef p, int item, char* smem) {
  const int tid = vq_tid(), lane = tid & 63, wave = __builtin_amdgcn_readfirstlane(tid >> 6), l15 = lane & 15, q4 = lane >> 4;
  const int bh = item >> 7, c = item & 127, b = bh >> 2, h = bh & 3;
  const int tok0 = b * SEQ + c * 64;
  float* wsh = (float*)smem;
  const float lf = p.gates[(size_t)(tok0 + lane) * 8 + 4 + h], ip = p.gates[(size_t)(tok0 + lane) * 8 + h];
  const float bs = scan_add(lf, lane);
  const float Bt = __shfl(bs, 63);
  const float aa = Bt - bs + ip;
  const float ml = wave_max(aa);
  wsh[wave * 64 + lane] = expf(aa - ml);
  if (tid == 0) { p.ab[(bh * 128 + c) * 2] = Bt; p.ab[(bh * 128 + c) * 2 + 1] = ml; }
  __syncthreads();
  f32x4 acc[8][4];
  f32x4 accn[2];
#pragma unroll
  for (int i = 0; i < 8; ++i)
#pragma unroll
    for (int j = 0; j < 4; ++j) acc[i][j] = (f32x4){0.f, 0.f, 0.f, 0.f};
  accn[0] = accn[1] = (f32x4){0.f, 0.f, 0.f, 0.f};
  bf16x8 ones;
#pragma unroll
  for (int j = 0; j < 8; ++j) ones[j] = (l15 == 0) ? (short)0x3F80 : (short)0;
#pragma unroll
  for (int ks = 0; ks < 2; ++ks) {
    float wk[8];
#pragma unroll
    for (int j = 0; j < 8; ++j) wk[j] = wsh[wave * 64 + ks * 32 + q4 * 8 + j];
    bf16x8 bfr[4];
#pragma unroll
    for (int nb = 0; nb < 4; ++nb)
      bfr[nb] = *(const bf16x8*)(p.vt + ((size_t)(bh * 256 + wave * 64 + nb * 16 + l15)) * SEQ + c * 64 + ks * 32 + q4 * 8);
#pragma unroll
    for (int mb = 0; mb < 8; ++mb) {
      bf16x8 raw = *(const bf16x8*)(p.kt + ((size_t)(bh * 128 + mb * 16 + l15)) * SEQ + c * 64 + ks * 32 + q4 * 8);
      bf16x8 af;
#pragma unroll
      for (int j = 0; j < 8; ++j) af[j] = (short)f2bf(bf2f((bf16)raw[j]) * wk[j]);
#pragma unroll
      for (int nb = 0; nb < 4; ++nb) acc[mb][nb] = MFMA(af, bfr[nb], acc[mb][nb]);
      if ((mb >> 1) == wave) accn[mb & 1] = MFMA(af, ones, accn[mb & 1]);
    }
  }
#pragma unroll
  for (int mb = 0; mb < 8; ++mb)
#pragma unroll
    for (int nb = 0; nb < 4; ++nb) {
      const int dv = wave * 64 + nb * 16 + l15, dk0 = mb * 16 + q4 * 4;
      uint2 o; o.x = pack2(acc[mb][nb][0], acc[mb][nb][1]); o.y = pack2(acc[mb][nb][2], acc[mb][nb][3]);
      *(uint2*)(p.uck + ((size_t)((bh * 128 + c) * 256 + dv)) * 128 + dk0) = o;
    }
  if (l15 == 0) {
#pragma unroll
    for (int i = 0; i < 2; ++i)
#pragma unroll
      for (int jj = 0; jj < 4; ++jj)
        p.un[(size_t)(bh * 128 + c) * 128 + (wave * 2 + i) * 16 + q4 * 4 + jj] = accn[i][jj];
  }
  __syncthreads();
}

__device__ __forceinline__ void mlstm_sample_item(PRef p, int item, char* smem, bool dryrun) {
  const int tid = vq_tid(), lane = tid & 63, wave = __builtin_amdgcn_readfirstlane(tid >> 6);
  const int b = item >> 2, h = item & 3;
  const int tok0 = TP + b * 4;
  float* qs = (float*)smem;
  float* ksm = qs + 512;
  float* qk = ksm + 512;
  float* qn = qk + 16;
  float* red = qn + 4;
  float* qw = red + 32;
  for (int i = tid; i < 1024; i += 256) {
    const int t = (i >> 7) & 3, d = i & 127, isk = i >> 9;
    const float* pr = p.part + (size_t)(b * 4 + t) * 3072 + isk * 512 + h * 128 + d;
    float v = pr[0] + pr[(size_t)512 * 3072] + pr[(size_t)2 * 512 * 3072] + pr[(size_t)3 * 512 * 3072];
    if (isk) v *= 0.08838834764831845f;
    (isk ? ksm : qs)[t * 128 + d] = v;
  }
  float lf[4], ip[4], bt[4];
#pragma unroll
  for (int t = 0; t < 4; ++t) { ip[t] = p.gates[(size_t)(tok0 + t) * 8 + h]; lf[t] = p.gates[(size_t)(tok0 + t) * 8 + 4 + h]; }
  bt[0] = lf[0]; bt[1] = bt[0] + lf[1]; bt[2] = bt[1] + lf[2]; bt[3] = bt[2] + lf[3];
  const float m0 = p.in[I_STM][b * 4 + h];
  float gs[4], Mt[4], winit[4], emt[4];
  float G = -INFINITY;
#pragma unroll
  for (int t = 0; t < 4; ++t) {
    gs[t] = ip[t] - bt[t];
    G = fmaxf(G, gs[t]);
    Mt[t] = fmaxf(m0, G);
    winit[t] = expf(m0 - Mt[t]);
    emt[t] = expf(-(bt[t] + Mt[t]));
  }
  const float mnew = bt[3] + Mt[3];
  float wend[4];
#pragma unroll
  for (int s = 0; s < 4; ++s) wend[s] = expf(bt[3] - bt[s] + ip[s] - mnew);
  const float decay = expf(bt[3] + m0 - mnew);
  __syncthreads();
  {
    const int pr = tid >> 4, sub = tid & 15, t = pr >> 2, s = pr & 3;
    float a = 0.f;
#pragma unroll
    for (int j = 0; j < 8; ++j) a += qs[t * 128 + sub * 8 + j] * ksm[s * 128 + sub * 8 + j];
    a += __shfl_xor(a, 1); a += __shfl_xor(a, 2); a += __shfl_xor(a, 4); a += __shfl_xor(a, 8);
    if (sub == 0) qk[pr] = a;
    if (pr < 4) {
      float a2 = 0.f;
#pragma unroll
      for (int j = 0; j < 8; ++j) a2 += qs[pr * 128 + sub * 8 + j] * p.in[I_STN][(size_t)(b * 4 + h) * 128 + sub * 8 + j];
      a2 += __shfl_xor(a2, 1); a2 += __shfl_xor(a2, 2); a2 += __shfl_xor(a2, 4); a2 += __shfl_xor(a2, 8);
      if (sub == 0) qn[pr] = a2;
    }
  }
  for (int i = tid; i < 1024; i += 256) {
    const int dk = i >> 3, j = i & 7;
    qw[i] = (j < 4) ? qs[j * 128 + dk] : wend[j - 4] * ksm[(j - 4) * 128 + dk];
  }
  __syncthreads();
  float sw[4][4], den[4];
#pragma unroll
  for (int t = 0; t < 4; ++t) {
    float dsum = 0.f;
#pragma unroll
    for (int s = 0; s < 4; ++s) {
      sw[t][s] = (s <= t) ? qk[t * 4 + s] * expf(gs[s] - Mt[t]) : 0.f;
      dsum += sw[t][s];
    }
    den[t] = dsum + winit[t] * qn[t];
  }
  const int dv = tid;
  float vv[4];
#pragma unroll
  for (int s = 0; s < 4; ++s) {
    const float* pr = p.part + (size_t)(b * 4 + s) * 3072 + 2048 + h * 256 + dv;
    vv[s] = pr[0] + pr[(size_t)512 * 3072] + pr[(size_t)2 * 512 * 3072] + pr[(size_t)3 * 512 * 3072];
  }
  const float* __restrict__ C0 = p.in[I_STC] + (size_t)(b * 4 + h) * 128 * 256 + dv;
  float* __restrict__ C1 = p.out + O_CS + (size_t)(b * 4 + h) * 128 * 256 + dv;
  float qc[4] = {0.f, 0.f, 0.f, 0.f};
#pragma unroll 1
  for (int dk0 = 0; dk0 < 128; dk0 += 32) {
    float cb[32];
#pragma unroll
    for (int j = 0; j < 32; ++j) cb[j] = __builtin_nontemporal_load(C0 + (dk0 + j) * 256);
#pragma unroll
    for (int j = 0; j < 32; ++j) {
      const float c = cb[j];
      const float4 q4v = *(const float4*)(qw + (dk0 + j) * 8);
      const float4 k4v = *(const float4*)(qw + (dk0 + j) * 8 + 4);
      qc[0] += q4v.x * c; qc[1] += q4v.y * c; qc[2] += q4v.z * c; qc[3] += q4v.w * c;
      __builtin_nontemporal_store(decay * c + k4v.x * vv[0] + k4v.y * vv[1] + k4v.z * vv[2] + k4v.w * vv[3], C1 + (dk0 + j) * 256);
    }
  }
  float hh[4];
  float rs[8];
#pragma unroll
  for (int t = 0; t < 4; ++t) {
    float num = winit[t] * qc[t];
#pragma unroll
    for (int s = 0; s < 4; ++s) num += sw[t][s] * vv[s];
    hh[t] = num / fmaxf(fabsf(den[t]), emt[t]);
    rs[t] = hh[t]; rs[4 + t] = hh[t] * hh[t];
  }
#pragma unroll
  for (int i = 0; i < 8; ++i) rs[i] = wave_sum(rs[i]);
  if (lane == 0) {
#pragma unroll
    for (int i = 0; i < 8; ++i) red[wave * 8 + i] = rs[i];
  }
  __syncthreads();
  const float nw = p.in[I_MLNW][h * 256 + dv];
#pragma unroll
  for (int t = 0; t < 4; ++t) {
    const float s1 = red[t] + red[8 + t] + red[16 + t] + red[24 + t];
    const float s2 = red[4 + t] + red[12 + t] + red[20 + t] + red[28 + t];
    const float mu = s1 * (1.f / 256.f);
    const float var = fmaxf(s2 * (1.f / 256.f) - mu * mu, 0.f);
    const float* pro = p.part + (size_t)(b * 4 + t) * 3072 + 1024 + h * 256 + dv;
    const float o = pro[0] + pro[(size_t)512 * 3072] + pro[(size_t)2 * 512 * 3072] + pro[(size_t)3 * 512 * 3072];
    p.H[(size_t)(tok0 + t) * 1024 + h * 256 + dv] = f2bf((hh[t] - mu) * rsqrtf(var + LN_EPS) * nw * sigmoidf_(o));
  }
  if (tid < 128) {
    float nn = decay * p.in[I_STN][(size_t)(b * 4 + h) * 128 + tid];
#pragma unroll
    for (int s = 0; s < 4; ++s) nn += wend[s] * ksm[s * 128 + tid];
    p.out[O_NS + (size_t)(b * 4 + h) * 128 + tid] = nn;
  }
  if (tid == 0) p.out[O_MS + b * 4 + h] = mnew;
  __syncthreads();
}

__device__ __forceinline__ void mlstm_scan_phase(PRef p, char* smem, bool dryrun) {
  const int tid = vq_tid();
  float* fa = (float*)smem;
  float* fu = fa + 128;
  float* aB = fu + 128;
  float* aM = aB + 128;
  for (int w = vq_bid(); w < 256; w += vq_gdim()) {
    const int bh = w >> 5, sub = w & 31;
    if (tid < 128) { aB[tid] = p.ab[(bh * 128 + tid) * 2]; aM[tid] = p.ab[(bh * 128 + tid) * 2 + 1]; }
    __syncthreads();
    if (tid == 0) {
      float m = 0.f;
      for (int k = 0; k < 128; ++k) {
        const float Bk = aB[k], ml = aM[k];
        const float mn = fmaxf(Bk + m, ml);
        fa[k] = __expf(Bk + m - mn); fu[k] = __expf(ml - mn);
        aB[k] = m;
        m = mn;
      }
      aM[0] = m;
    }
    __syncthreads();
    if (sub == 0) {
      if (tid < 128) p.mk[bh * 129 + tid] = aB[tid];
      if (tid == 0) { p.mk[bh * 129 + 128] = aM[0]; p.out[O_MP + bh] = aM[0]; }
    }
    const int e4 = sub * 256 + tid;
    float c0 = 0.f, c1 = 0.f, c2 = 0.f, c3 = 0.f;
    bf16* base = p.uck + (size_t)bh * 128 * 32768 + (size_t)e4 * 4;
    for (int k0 = 0; k0 < 128; k0 += 16) {
      uint2 u[16];
#pragma unroll
      for (int j = 0; j < 16; ++j) u[j] = *(const uint2*)(base + (size_t)(k0 + j) * 32768);
#pragma unroll
      for (int j = 0; j < 16; ++j) {
        uint2 o; o.x = pack2(c0, c1); o.y = pack2(c2, c3);
        if (!dryrun) *(uint2*)(base + (size_t)(k0 + j) * 32768) = o;
        const float a = fa[k0 + j], f = fu[k0 + j];
        c0 = a * c0 + f * __uint_as_float(u[j].x << 16);
        c1 = a * c1 + f * __uint_as_float(u[j].x & 0xffff0000u);
        c2 = a * c2 + f * __uint_as_float(u[j].y << 16);
        c3 = a * c3 + f * __uint_as_float(u[j].y & 0xffff0000u);
      }
    }
    {
      const int e = e4 * 4, dv = e >> 7, dk = e & 127;
      float* o = p.out + O_CP + (size_t)bh * 32768;
      o[(dk + 0) * 256 + dv] = c0; o[(dk + 1) * 256 + dv] = c1; o[(dk + 2) * 256 + dv] = c2; o[(dk + 3) * 256 + dv] = c3;
    }
    if (sub == 1 && tid < 128) {
      float n = 0.f;
      for (int k0 = 0; k0 < 128; k0 += 16) {
        float un[16];
#pragma unroll
        for (int j = 0; j < 16; ++j) un[j] = p.un[(size_t)(bh * 128 + k0 + j) * 128 + tid];
#pragma unroll
        for (int j = 0; j < 16; ++j) {
          p.nk[(size_t)(bh * 128 + k0 + j) * 128 + tid] = n;
          n = fa[k0 + j] * n + fu[k0 + j] * un[j];
        }
      }
      p.out[O_NP + bh * 128 + tid] = n;
    }
    __syncthreads();
  }
}

__device__ __forceinline__ void mlstm_C_item(PRef p, int item, char* smem, bool dryrun) {
  const int tid = vq_tid(), lane = tid & 63, wave = __builtin_amdgcn_readfirstlane(tid >> 6), l15 = lane & 15, q4 = lane >> 4;
  const int bh = item >> 7, c = item & 127, b = bh >> 2, h = bh & 3;
  const int tok0 = b * SEQ + c * 64;
  bf16* Sb = (bf16*)smem;
  float* gsv = (float*)(smem + 9216);
  float* Mtv = gsv + 64;
  float* wiv = Mtv + 64;
  float* emv = wiv + 64;
  float* red = emv + 64;
  const float mk = p.mk[bh * 129 + c];
  if (wave == 0) {
    const float lf = p.gates[(size_t)(tok0 + lane) * 8 + 4 + h], ip = p.gates[(size_t)(tok0 + lane) * 8 + h];
    const float bt = scan_add(lf, lane);
    const float g = ip - bt;
    const float G = scan_max(g, lane);
    const float M = fmaxf(mk, G);
    gsv[lane] = g; Mtv[lane] = M; wiv[lane] = expf(mk - M); emv[lane] = expf(-(bt + M));
  }
  __syncthreads();
  {
    f32x4 sacc[4];
#pragma unroll
    for (int i = 0; i < 4; ++i) sacc[i] = (f32x4){0.f, 0.f, 0.f, 0.f};
#pragma unroll
    for (int ks = 0; ks < 4; ++ks) {
      const bf16x8 af = *(const bf16x8*)(p.proj + (size_t)(tok0 + wave * 16 + l15) * 2048 + h * 128 + ks * 32 + q4 * 8);
#pragma unroll
      for (int sb = 0; sb < 4; ++sb) {
        if (sb <= wave) {
          const bf16x8 bfr = *(const bf16x8*)(p.proj + (size_t)(tok0 + sb * 16 + l15) * 2048 + 512 + h * 128 + ks * 32 + q4 * 8);
          sacc[sb] = MFMA(af, bfr, sacc[sb]);
        }
      }
    }
#pragma unroll
    for (int sb = 0; sb < 4; ++sb) {
      const int s = sb * 16 + l15;
      const float g = gsv[s];
#pragma unroll
      for (int jj = 0; jj < 4; ++jj) {
        const int t = wave * 16 + q4 * 4 + jj;
        const float v = (s <= t) ? sacc[sb][jj] * __expf(g - Mtv[t]) : 0.f;
        Sb[t * 72 + s] = f2bf(v);
      }
    }
  }
  __syncthreads();
  f32x4 acc[4][4], accd[4];
#pragma unroll
  for (int i = 0; i < 4; ++i) {
    accd[i] = (f32x4){0.f, 0.f, 0.f, 0.f};
#pragma unroll
    for (int j = 0; j < 4; ++j) acc[i][j] = (f32x4){0.f, 0.f, 0.f, 0.f};
  }
  const bf16* __restrict__ ckb = p.uck + ((size_t)(bh * 128 + c) * 256) * 128;
  const float* __restrict__ nkp = p.nk + (size_t)(bh * 128 + c) * 128;
  const bf16* __restrict__ projr = p.proj;
  bf16x8 vfr[2][4];
#pragma unroll
  for (int ks = 0; ks < 2; ++ks)
#pragma unroll
    for (int nb = 0; nb < 4; ++nb) vfr[ks][nb] = *(const bf16x8*)(p.vt + ((size_t)(bh * 256 + wave * 64 + nb * 16 + l15)) * SEQ + c * 64 + ks * 32 + q4 * 8);
#pragma unroll 2
  for (int ks = 0; ks < 4; ++ks) {
    bf16x8 bfr[4], nfr;
#pragma unroll
    for (int nb = 0; nb < 4; ++nb) bfr[nb] = *(const bf16x8*)(ckb + (size_t)(wave * 64 + nb * 16 + l15) * 128 + ks * 32 + q4 * 8);
#pragma unroll
    for (int j = 0; j < 8; ++j) nfr[j] = (l15 == 0) ? (short)f2bf(nkp[ks * 32 + q4 * 8 + j]) : (short)0;
#pragma unroll
    for (int tb = 0; tb < 4; ++tb) {
      const bf16x8 af = *(const bf16x8*)(projr + (size_t)(tok0 + tb * 16 + l15) * 2048 + h * 128 + ks * 32 + q4 * 8);
#pragma unroll
      for (int nb = 0; nb < 4; ++nb) acc[tb][nb] = MFMA(af, bfr[nb], acc[tb][nb]);
      accd[tb] = MFMA(af, nfr, accd[tb]);
    }
  }
#pragma unroll
  for (int tb = 0; tb < 4; ++tb)
#pragma unroll
    for (int jj = 0; jj < 4; ++jj) {
      const float wi = wiv[tb * 16 + q4 * 4 + jj];
      accd[tb][jj] *= wi;
#pragma unroll
      for (int nb = 0; nb < 4; ++nb) acc[tb][nb][jj] *= wi;
    }
  bf16x8 ones;
#pragma unroll
  for (int j = 0; j < 8; ++j) ones[j] = (l15 == 0) ? (short)0x3F80 : (short)0;
#pragma unroll
  for (int ks = 0; ks < 2; ++ks) {
#pragma unroll
    for (int tb = 0; tb < 4; ++tb) {
      const bf16x8 af = *(const bf16x8*)(Sb + (tb * 16 + l15) * 72 + ks * 32 + q4 * 8);
#pragma unroll
      for (int nb = 0; nb < 4; ++nb) acc[tb][nb] = MFMA(af, vfr[ks][nb], acc[tb][nb]);
      accd[tb] = MFMA(af, ones, accd[tb]);
    }
  }
#pragma unroll
  for (int tb = 0; tb < 4; ++tb)
#pragma unroll
    for (int jj = 0; jj < 4; ++jj) {
      const int t = tb * 16 + q4 * 4 + jj;
      const float den = __shfl(accd[tb][jj], lane & 48);
      const float inv = 1.f / fmaxf(fabsf(den), emv[t]);
      float s1 = 0.f, s2 = 0.f;
#pragma unroll
      for (int nb = 0; nb < 4; ++nb) { const float hv = acc[tb][nb][jj] * inv; acc[tb][nb][jj] = hv; s1 += hv; s2 += hv * hv; }
      s1 += __shfl_xor(s1, 1); s1 += __shfl_xor(s1, 2); s1 += __shfl_xor(s1, 4); s1 += __shfl_xor(s1, 8);
      s2 += __shfl_xor(s2, 1); s2 += __shfl_xor(s2, 2); s2 += __shfl_xor(s2, 4); s2 += __shfl_xor(s2, 8);
      if (l15 == 0) { red[(wave * 64 + t) * 2] = s1; red[(wave * 64 + t) * 2 + 1] = s2; }
    }
  __syncthreads();
  float nwv[4];
#pragma unroll
  for (int nb = 0; nb < 4; ++nb) nwv[nb] = p.in[I_MLNW][h * 256 + wave * 64 + nb * 16 + l15];
  bf16* __restrict__ yb = p.H;
#pragma unroll
  for (int tb = 0; tb < 4; ++tb) {
#pragma unroll
    for (int jj = 0; jj < 4; ++jj) {
      const int t = tb * 16 + q4 * 4 + jj;
      const float s1 = red[t * 2] + red[(64 + t) * 2] + red[(128 + t) * 2] + red[(192 + t) * 2];
      const float s2 = red[t * 2 + 1] + red[(64 + t) * 2 + 1] + red[(128 + t) * 2 + 1] + red[(192 + t) * 2 + 1];
      const float mu = s1 * (1.f / 256.f);
      const float rstd = rsqrtf(fmaxf(s2 * (1.f / 256.f) - mu * mu, 0.f) + LN_EPS);
#pragma unroll
      for (int nb = 0; nb < 4; ++nb) {
        const int dv = wave * 64 + nb * 16 + l15;
        const float o = bf2f(projr[(size_t)(tok0 + t) * 2048 + 1024 + h * 256 + dv]);
        const float yv = (acc[tb][nb][jj] - mu) * rstd * nwv[nb] * sigmoidf_(o);
        if (!dryrun) yb[(size_t)(tok0 + t) * 1024 + h * 256 + dv] = f2bf(yv);
        else if (yv == 1.2345e30f) p.mods[0] = 1.f;
      }
    }
  }
  __syncthreads();
}

__device__ __forceinline__ void attn_prompt_item(PRef p, int item, char* smem) {
  const int tid = vq_tid(), lane = tid & 63, wave = __builtin_amdgcn_readfirstlane(tid >> 6), l15 = lane & 15, q4 = lane >> 4;
  const int b = item >> 8, kvh = (item >> 6) & 3, nb = item & 63;
  const int qh = kvh * 4 + wave;
  const float sink = p.in[I_SINKS][qh];
  bf16* Pb = (bf16*)smem + wave * 16 * 168;
  const bf16x8 zero8 = (bf16x8){0, 0, 0, 0, 0, 0, 0, 0};
  for (int qt = 0; qt < 8; ++qt) {
    const int q0 = nb * 128 + qt * 16;
    bf16x8 qf[2];
#pragma unroll
    for (int ks = 0; ks < 2; ++ks) qf[ks] = *(const bf16x8*)(p.q + (size_t)(b * SEQ + q0 + l15) * D + qh * 64 + ks * 32 + q4 * 8);
    bf16x8 vfa[5][4];
#pragma unroll
    for (int ks = 0; ks < 5; ++ks) {
      const int kidx = q0 - 128 + ks * 32 + q4 * 8;
      const bool ok = (kidx >= 0) && !(ks == 4 && q4 >= 2);
#pragma unroll
      for (int db = 0; db < 4; ++db) {
        vfa[ks][db] = zero8;
        if (ok) vfa[ks][db] = *(const bf16x8*)(p.vta + ((size_t)((b * 4 + kvh) * 64 + db * 16 + l15)) * SEQ + kidx);
      }
    }
    f32x4 s[9];
#pragma unroll
    for (int kb = 0; kb < 9; ++kb) {
      s[kb] = (f32x4){0.f, 0.f, 0.f, 0.f};
      const int key0 = q0 - 128 + kb * 16;
      if (key0 >= 0) {
#pragma unroll
        for (int ks = 0; ks < 2; ++ks) {
          const bf16x8 kf = *(const bf16x8*)(p.ks + (size_t)(b * SEQ + key0 + l15) * 256 + kvh * 64 + ks * 32 + q4 * 8);
          s[kb] = MFMA(qf[ks], kf, s[kb]);
        }
      }
    }
    float mx[4], sum[4];
#pragma unroll
    for (int jj = 0; jj < 4; ++jj) {
      const int r = q4 * 4 + jj;
      float m = -INFINITY;
#pragma unroll
      for (int kb = 0; kb < 9; ++kb) {
        const int key0 = q0 - 128 + kb * 16;
        bool valid = key0 >= 0;
        if (kb == 0) valid = valid && (l15 > r);
        if (kb == 8) valid = valid && (l15 <= r);
        const float v = valid ? s[kb][jj] : -INFINITY;
        s[kb][jj] = v;
        m = fmaxf(m, v);
      }
      m = fmaxf(m, __shfl_xor(m, 1)); m = fmaxf(m, __shfl_xor(m, 2)); m = fmaxf(m, __shfl_xor(m, 4)); m = fmaxf(m, __shfl_xor(m, 8));
      m = fmaxf(m, sink);
      float sm = 0.f;
#pragma unroll
      for (int kb = 0; kb < 9; ++kb) {
        const float e = __expf(s[kb][jj] - m);
        sm += e;
        Pb[r * 168 + kb * 16 + l15] = f2bf(e);
      }
      Pb[r * 168 + 144 + l15] = 0;
      sm += __shfl_xor(sm, 1); sm += __shfl_xor(sm, 2); sm += __shfl_xor(sm, 4); sm += __shfl_xor(sm, 8);
      mx[jj] = m; sum[jj] = sm + __expf(sink - m);
    }
    __syncthreads();
    f32x4 o[4];
#pragma unroll
    for (int db = 0; db < 4; ++db) o[db] = (f32x4){0.f, 0.f, 0.f, 0.f};
#pragma unroll
    for (int ks = 0; ks < 5; ++ks) {
      const bf16x8 pf = *(const bf16x8*)(Pb + l15 * 168 + ks * 32 + q4 * 8);
#pragma unroll
      for (int db = 0; db < 4; ++db) o[db] = MFMA(pf, vfa[ks][db], o[db]);
    }
#pragma unroll
    for (int db = 0; db < 4; ++db)
#pragma unroll
      for (int jj = 0; jj < 4; ++jj) {
        const int r = q4 * 4 + jj;
        p.att[(size_t)(b * SEQ + q0 + r) * D + qh * 64 + db * 16 + l15] = f2bf(o[db][jj] / sum[jj]);
      }
    __syncthreads();
  }
}

__device__ __forceinline__ void attn_sample_item(PRef p, int item, char* smem) {
  const int tid = vq_tid();
  const int b = item >> 2, kvh = item & 3;
  float* qs = (float*)smem;
  float* sc = qs + 1024;
  float* rinv = sc + 16 * 132;
  const float* ck = p.in[I_CK]; const float* cv = p.in[I_CV];
  float* wk = p.out + O_WKS; float* wv = p.out + O_WVS;
  for (int i = tid; i < 124 * 16; i += 256) {
    const int r = i >> 4, c4 = (i & 15) * 4;
    { const float4 t4 = *(const float4*)(ck + ((size_t)(b * 128 + r + 4) * 4 + kvh) * 64 + c4);
      __builtin_nontemporal_store((f32x4){t4.x, t4.y, t4.z, t4.w}, (f32x4*)(wk + ((size_t)(b * 128 + r) * 4 + kvh) * 64 + c4)); }
    { const float4 t4 = *(const float4*)(cv + ((size_t)(b * 128 + r + 4) * 4 + kvh) * 64 + c4);
      __builtin_nontemporal_store((f32x4){t4.x, t4.y, t4.z, t4.w}, (f32x4*)(wv + ((size_t)(b * 128 + r) * 4 + kvh) * 64 + c4)); }
  }
  for (int i = tid; i < 1024; i += 256) {
    const int r = i >> 6, d = i & 63, t = r >> 2, g = r & 3;
    const int col = (kvh * 4 + g) * 64 + d;
    const float* pr = p.part + (size_t)(b * 4 + t) * 1024;
    float v = pr[col] + pr[(size_t)512 * 1024 + col] + pr[(size_t)2 * 512 * 1024 + col] + pr[(size_t)3 * 512 * 1024 + col];
    if (d < 16) {
      const int pc = d < 8 ? col + 8 : col - 8;
      const float v2 = pr[pc] + pr[(size_t)512 * 1024 + pc] + pr[(size_t)2 * 512 * 1024 + pc] + pr[(size_t)3 * 512 * 1024 + pc];
      const float2 cs = p.rot[(8192 + t) * 8 + (d & 7)];
      v = d < 8 ? v * cs.x - v2 * cs.y : v * cs.x + v2 * cs.y;
    }
    qs[i] = v * 0.125f;
  }
  __syncthreads();
  const int r = tid >> 4, sub = tid & 15, t = r >> 2, g = r & 3;
  const float sink = p.in[I_SINKS][kvh * 4 + g];
  float lmax = -INFINITY;
  for (int i = 0; i < 9; ++i) {
    const int key = sub + 16 * i;
    if (key < 132) {
      const float* kp = key < 128 ? ck + ((size_t)(b * 128 + key) * 4 + kvh) * 64 : wk + ((size_t)(b * 128 + 124 + key - 128) * 4 + kvh) * 64;
      float a = 0.f;
#pragma unroll
      for (int d4 = 0; d4 < 16; ++d4) {
        const float4 kv = *(const float4*)(kp + d4 * 4);
        const float4 qv = *(const float4*)(qs + r * 64 + d4 * 4);
        a += kv.x * qv.x + kv.y * qv.y + kv.z * qv.z + kv.w * qv.w;
      }
      const bool valid = key < 128 ? (key > t) : ((key - 128) <= t);
      a = valid ? a : -INFINITY;
      sc[r * 132 + key] = a;
      lmax = fmaxf(lmax, a);
    }
  }
  lmax = fmaxf(lmax, __shfl_xor(lmax, 1)); lmax = fmaxf(lmax, __shfl_xor(lmax, 2)); lmax = fmaxf(lmax, __shfl_xor(lmax, 4)); lmax = fmaxf(lmax, __shfl_xor(lmax, 8));
  lmax = fmaxf(lmax, sink);
  float lsum = 0.f;
  for (int i = 0; i < 9; ++i) {
    const int key = sub + 16 * i;
    if (key < 132) {
      const float e = __expf(sc[r * 132 + key] - lmax);
      sc[r * 132 + key] = e;
      lsum += e;
    }
  }
  lsum += __shfl_xor(lsum, 1); lsum += __shfl_xor(lsum, 2); lsum += __shfl_xor(lsum, 4); lsum += __shfl_xor(lsum, 8);
  if (sub == 0) rinv[r] = 1.f / (lsum + __expf(sink - lmax));
  __syncthreads();
  float4 o = make_float4(0.f, 0.f, 0.f, 0.f);
  {
    const float* vb0 = cv + ((size_t)(b * 128) * 4 + kvh) * 64 + sub * 4;
#pragma unroll 16
    for (int key = 0; key < 128; ++key) {
      const float4 vv = *(const float4*)(vb0 + (size_t)key * 256);
      const float pw = sc[r * 132 + key];
      o.x += pw * vv.x; o.y += pw * vv.y; o.z += pw * vv.z; o.w += pw * vv.w;
    }
    const float* vb1 = wv + ((size_t)(b * 128 + 124) * 4 + kvh) * 64 + sub * 4;
#pragma unroll
    for (int key = 0; key < 4; ++key) {
      const float4 vv = *(const float4*)(vb1 + (size_t)key * 256);
      const float pw = sc[r * 132 + 128 + key];
      o.x += pw * vv.x; o.y += pw * vv.y; o.z += pw * vv.z; o.w += pw * vv.w;
    }
  }
  const float ri = rinv[r];
  uint2 ov; ov.x = pack2(o.x * ri, o.y * ri); ov.y = pack2(o.z * ri, o.w * ri);
  *(uint2*)(p.att + (size_t)(TP + b * 4 + t) * D + (kvh * 4 + g) * 64 + sub * 4) = ov;
  __syncthreads();
}


#ifdef SELFCHECK
__device__ __forceinline__ unsigned dhash(unsigned a, unsigned b) { unsigned h = a * 2654435761u + b * 40503u + 12345u; h ^= h >> 15; h *= 2246822519u; h ^= h >> 13; return h; }
__device__ __forceinline__ bool dbad(float got, float want, float tol, float flo) { return !(fabsf(got - want) <= tol * (fabsf(want) + flo)); }
__device__ __forceinline__ float ddot(const bf16* a, const float* w, int ldw, int K) { float s = 0.f; for (int k = 0; k < K; ++k) s += bf2f(a[k]) * w[(size_t)k * ldw]; return s; }
__device__ __forceinline__ void dfail(PRef p, int code) { atomicMin(p.dbg, code); }
__device__ __forceinline__ void stashX(PRef p, int salt) {
  const int tid = threadIdx.x; const unsigned h = dhash(tid, salt);
  const int tok = (tid & 1) ? TP + (h % 512) : (h % TP); const int col = (h >> 12) % 1024;
  p.stash[tid] = p.out[(size_t)tok * D + col];
}
__device__ void selfcheck(PRef p, int ph, char* dsm) {
  const int tid = threadIdx.x;
  const unsigned h = dhash(tid, ph);
  const int tok = (tid & 1) ? TP + (h % 512) : (h % TP);
  const int brow = brow_of(tok);
  const float* mrow = p.mods + (size_t)brow * MODW;
  const int layer = ph >= 15 ? 1 : 0; const int lo = layer * 9216;
  if (ph == 0) {
    WDesc w; int di = tid & 15;
    w.src = p.wd[0].src; w.dst = p.wd[0].dst; w.K = p.wd[0].K; w.N = p.wd[0].N; w.ld = p.wd[0].ld;
#pragma unroll
    for (int i = 1; i < 16; ++i) if (di == i) { w.src = p.wd[i].src; w.dst = p.wd[i].dst; w.K = p.wd[i].K; w.N = p.wd[i].N; w.ld = p.wd[i].ld; }
    const int n = h % w.N, k = (h >> 8) % w.K;
    if (w.dst[(size_t)n * w.K + k] != f2bf(w.src[(size_t)k * w.ld + n])) dfail(p, 1);
    const int pos = h % 8196, fi = tid & 7;
    const float ang = (float)((double)pos * p.inv_freq[fi]);
    const float2 cs = p.rot[pos * 8 + fi];
    if (fabsf(cs.x - cosf(ang)) > 2e-3f || fabsf(cs.y - sinf(ang)) > 2e-3f) dfail(p, 26);
  } else if (ph == 1) {
    const int br = tid % NBR, col = h % MODW;
    const float* c = br < 2 ? p.in[I_CP] + br * 1024 : p.in[I_CS] + (br - 2) * 1024;
    const float* W = col < 9216 ? p.in[I_ADAW] + col : col < 18432 ? p.in[I_ADAW] + (size_t)1024 * 9216 + (col - 9216) : p.in[I_KVADAW] + (col - 18432);
    const int ld = col < 18432 ? 9216 : 2048;
    float s = col < 18432 ? p.in[I_ADAB][col] : p.in[I_KVADAB][col - 18432];
    for (int k = 0; k < 1024; ++k) { float v = c[k]; v = v / (1.f + expf(-v)); s += v * W[(size_t)k * ld]; }
    if (dbad(p.mods[(size_t)br * MODW + col], s, 0.02f, 0.5f)) dfail(p, 2);
  } else if (ph == 2) {
    const int col = (h >> 12) % 1024;
    const float x = tok < TP ? p.in[I_XP][(size_t)tok * D + col] : p.in[I_XS][(size_t)(tok - TP) * D + col];
    if (p.out[(size_t)tok * D + col] != x) dfail(p, 3);
    if (dbad(bf2f(p.H[(size_t)tok * D + col]), x * (1.f + mrow[1024 + col]) + mrow[col], 0.01f, 0.02f)) dfail(p, 3);
  } else if (ph == 3 || ph == 12 || ph == 15 || ph == 22) {
    const int j = (h >> 12) % F;
    const float* W = (ph == 3 ? p.in[I_F1U] : ph == 12 ? p.in[I_F2U] : ph == 15 ? p.in[I_F1U] + (size_t)1024 * 5632 : p.in[I_F2U] + (size_t)1024 * 5632);
    const float a = ddot(p.H + (size_t)tok * D, W + j, 5632, 1024), u = ddot(p.H + (size_t)tok * D, W + F + j, 5632, 1024);
    if (dbad(bf2f(p.hid[(size_t)tok * F + j]), a / (1.f + expf(-a)) * u, 0.03f, 1.0f)) dfail(p, ph + 1);
    if (ph == 15) {
      const int col = (h >> 5) % 512;
      float v = ddot(p.hkv + (size_t)tok * D, p.in[I_KVW] + col, 512, 1024);
      const int cc = col & 255, kvh = cc >> 6, d = cc & 63;
      if (col < 256 && d < 16) {
        const int pcol = d < 8 ? col + 8 : col - 8;
        const float v2 = ddot(p.hkv + (size_t)tok * D, p.in[I_KVW] + pcol, 512, 1024);
        const float ang = (float)((double)pos_of(tok) * p.inv_freq[d & 7]);
        v = d < 8 ? v * cosf(ang) - v2 * sinf(ang) : v * cosf(ang) + v2 * sinf(ang);
      }
      float got;
      if (col < 256) got = bf2f(p.ks[(size_t)tok * 256 + cc]);
      else if (tok < TP) got = bf2f(p.vta[((size_t)((tok >> 13) * 4 + kvh) * 64 + d) * SEQ + (tok & 8191)]);
      else got = p.out[O_WVS + ((size_t)(((tok - TP) >> 2) * 128 + 124 + ((tok - TP) & 3)) * 4 + kvh) * 64 + d];
      if (dbad(got, v, 0.03f, 1.0f)) dfail(p, 27);
      if (tok >= TP) {
        const float g2 = p.out[(col < 256 ? O_WKS : O_WVS) + ((size_t)(((tok - TP) >> 2) * 128 + 124 + ((tok - TP) & 3)) * 4 + kvh) * 64 + d];
        if (dbad(g2, v, 0.03f, 1.0f)) dfail(p, 28);
      }
    }
    stashX(p, ph + 1);
  } else if (ph == 4 || ph == 13 || ph == 16 || ph == 23 || ph == 10 || ph == 20) {
    const unsigned h2 = dhash(tid, ph); const int tk = (tid & 1) ? TP + (h2 % 512) : (h2 % TP); const int col = (h2 >> 12) % 1024;
    const float* mr = p.mods + (size_t)brow_of(tk) * MODW;
    float acc, gate, wgt;
    if (ph == 10) { acc = ddot(p.proj + (size_t)tk * 2048 + 1024, p.in[I_MLWOUT] + col, 1024, 1024); gate = mr[lo + 5 * 1024 + col]; wgt = 1.f; }
    else if (ph == 20) { acc = ddot(p.att + (size_t)tk * D, p.in[I_ATTWO] + col, 1024, 1024); gate = mr[lo + 5 * 1024 + col]; wgt = 1.f; }
    else {
      const float* W = (ph == 4 ? p.in[I_F1D] : ph == 13 ? p.in[I_F2D] : ph == 16 ? p.in[I_F1D] + (size_t)F * 1024 : p.in[I_F2D] + (size_t)F * 1024);
      acc = ddot(p.hid + (size_t)tk * F, W + col, 1024, F); gate = mr[lo + ((ph == 4 || ph == 16) ? 2 : 8) * 1024 + col]; wgt = 0.5f;
    }
    const float want = ALPHA * p.stash[tid] + wgt * gate * acc;
    if (dbad(p.out[(size_t)tk * D + col], want, 0.02f, 1.0f)) dfail(p, ph + 1);
  } else if (ph == 5 || ph == 11 || ph == 14 || ph == 17 || ph == 21 || ph == 24) {
    const int j = (ph == 5 || ph == 17) ? 0 : (ph == 11 || ph == 21) ? 1 : 2;
    const float* lg = p.in[I_LNG] + (layer * 3 + j) * D; const float* lb = p.in[I_LNB] + (layer * 3 + j) * D;
    float s1 = 0.f, s2 = 0.f;
    for (int c = 0; c < 1024; ++c) { const float z = (p.out[(size_t)tok * D + c] - lb[c]) / lg[c]; s1 += z; s2 += z * z; }
    s1 *= (1.f / 1024.f); s2 = s2 * (1.f / 1024.f) - s1 * s1;
    if (fabsf(s1) > 0.01f || fabsf(s2 - 1.f) > 0.02f) dfail(p, ph + 1);
    const int hoff = ph == 5 ? 3072 : ph == 11 ? 6144 : ph == 14 ? 9216 : ph == 17 ? 9216 + 3072 : ph == 21 ? 9216 + 6144 : -1;
    const int col = (h >> 12) % 1024;
    const float x = p.out[(size_t)tok * D + col];
    if (hoff >= 0 && dbad(bf2f(p.H[(size_t)tok * D + col]), x * (1.f + mrow[hoff + 1024 + col]) + mrow[hoff + col], 0.01f, 0.02f)) dfail(p, 29);
    if (ph == 14 && dbad(bf2f(p.hkv[(size_t)tok * D + col]), x * (1.f + mrow[18432 + 1024 + col]) + mrow[18432 + col], 0.01f, 0.02f)) dfail(p, 30);
    if (ph == 5) {
      const int gi = tid & 7; float s = p.in[I_MLBG][gi];
      for (int c = 0; c < 1024; ++c) s += (p.out[(size_t)tok * D + c] * (1.f + mrow[3072 + 1024 + c]) + mrow[3072 + c]) * p.in[I_MLWIN][(size_t)c * 3080 + 3072 + gi];
      if (gi >= 4) s = -log1pf(expf(-s));
      if (dbad(p.gates[(size_t)tok * 8 + gi], s, 0.01f, 0.01f)) dfail(p, 31);
    }
    stashX(p, ph == 5 ? 10 : ph == 17 ? 20 : ph + 1);
  } else if (ph == 6) {
    const int col = (h >> 12) % 3072;
    float v = ddot(p.H + (size_t)tok * D, p.in[I_MLWIN] + col, 3080, 1024);
    if (col >= 512 && col < 1024) v *= 0.08838834764831845f;
    float got;
    if (col < 1024) got = bf2f(p.proj[(size_t)tok * 2048 + col]);
    else if (col >= 2048) got = bf2f(p.proj[(size_t)tok * 2048 + col - 1024]);
    else if (tok >= TP) got = bf2f(p.vsamp[(size_t)(tok - TP) * 1024 + col - 1024]);
    else { const int c2 = col - 1024; got = bf2f(p.vt[((size_t)((tok >> 13) * 4 + (c2 >> 8)) * 256 + (c2 & 255)) * SEQ + (tok & 8191)]); }
    if (dbad(got, v, 0.03f, 0.5f)) dfail(p, 7);
    if (col >= 512 && col < 1024 && tok < TP) {
      const int c2 = col - 512;
      if (dbad(bf2f(p.kt[((size_t)((tok >> 13) * 4 + (c2 >> 7)) * 128 + (c2 & 127)) * SEQ + (tok & 8191)]), v, 0.03f, 0.5f)) dfail(p, 32);
    }
  } else if (ph == 7) {
    {
      const int bh = h & 7, c = (h >> 3) & 127, dv = (h >> 10) & 255, dk = (h >> 18) & 127, b = bh >> 2, hh = bh & 3;
      const int tok0 = b * SEQ + c * 64;
      float B = 0.f;
      for (int s = 0; s < 64; ++s) B += p.gates[(size_t)(tok0 + s) * 8 + 4 + hh];
      float bs = 0.f, ml = -INFINITY;
      for (int s = 0; s < 64; ++s) { bs += p.gates[(size_t)(tok0 + s) * 8 + 4 + hh]; ml = fmaxf(ml, B - bs + p.gates[(size_t)(tok0 + s) * 8 + hh]); }
      bs = 0.f; float u = 0.f, un = 0.f;
      for (int s = 0; s < 64; ++s) {
        bs += p.gates[(size_t)(tok0 + s) * 8 + 4 + hh];
        const float w = expf(B - bs + p.gates[(size_t)(tok0 + s) * 8 + hh] - ml);
        const float k = bf2f(p.proj[(size_t)(tok0 + s) * 2048 + 512 + hh * 128 + dk]);
        u += w * k * bf2f(p.vt[((size_t)(bh * 256 + dv)) * SEQ + c * 64 + s]); un += w * k;
      }
      if (dbad(p.ab[(bh * 128 + c) * 2], B, 1e-3f, 1e-2f) || dbad(p.ab[(bh * 128 + c) * 2 + 1], ml, 1e-3f, 1e-2f)) dfail(p, 33);
      if (dbad(bf2f(p.uck[((size_t)((bh * 128 + c) * 256 + dv)) * 128 + dk]), u, 0.03f, 0.05f)) dfail(p, 8);
      if (dbad(p.un[(size_t)(bh * 128 + c) * 128 + dk], un, 0.03f, 0.1f)) dfail(p, 34);
    }
    {
      const int b = (h >> 4) & 127, hh = h & 3, dk = (h >> 11) & 127, dv = (h >> 18) & 255;
      const int tok0 = TP + b * 4;
      float lf[4], ip[4], bt[4];
#pragma unroll
      for (int t = 0; t < 4; ++t) { ip[t] = p.gates[(size_t)(tok0 + t) * 8 + hh]; lf[t] = p.gates[(size_t)(tok0 + t) * 8 + 4 + hh]; }
      bt[0] = lf[0]; bt[1] = bt[0] + lf[1]; bt[2] = bt[1] + lf[2]; bt[3] = bt[2] + lf[3];
      const float m0 = p.in[I_STM][b * 4 + hh];
      float mt3 = bt[3] + m0;
#pragma unroll
      for (int s = 0; s < 4; ++s) mt3 = fmaxf(mt3, bt[3] - bt[s] + ip[s]);
      float cn = expf(bt[3] + m0 - mt3) * p.in[I_STC][((size_t)(b * 4 + hh) * 128 + dk) * 256 + dv];
      float nn = expf(bt[3] + m0 - mt3) * p.in[I_STN][(size_t)(b * 4 + hh) * 128 + dk];
#pragma unroll
      for (int s = 0; s < 4; ++s) {
        const float we = expf(bt[3] - bt[s] + ip[s] - mt3);
        const float k = bf2f(p.proj[(size_t)(tok0 + s) * 2048 + 512 + hh * 128 + dk]);
        cn += we * k * bf2f(p.vsamp[(size_t)(b * 4 + s) * 1024 + hh * 256 + dv]); nn += we * k;
      }
      if (dbad(p.out[O_CS + ((size_t)(b * 4 + hh) * 128 + dk) * 256 + dv], cn, 0.02f, 0.01f)) dfail(p, 35);
      if (dbad(p.out[O_NS + (size_t)(b * 4 + hh) * 128 + dk], nn, 0.02f, 0.01f)) dfail(p, 36);
      if (dbad(p.out[O_MS + b * 4 + hh], mt3, 1e-3f, 1e-2f)) dfail(p, 37);
    }
  } else if (ph == 8) {
    const int bh = h & 7, k = (h >> 3) & 127, d = (h >> 10) & 127;
    float m = 0.f, n = 0.f;
    for (int j = 0; j < k; ++j) {
      const float Bj = p.ab[(bh * 128 + j) * 2], ml = p.ab[(bh * 128 + j) * 2 + 1];
      const float mn = fmaxf(Bj + m, ml);
      n = expf(Bj + m - mn) * n + expf(ml - mn) * p.un[(size_t)(bh * 128 + j) * 128 + d];
      m = mn;
    }
    if (dbad(p.nk[(size_t)(bh * 128 + k) * 128 + d], n, 0.01f, 0.01f)) dfail(p, 9);
    if (dbad(p.mk[bh * 129 + k], m, 1e-3f, 1e-2f)) dfail(p, 38);
    {
      const int c = 1 + (h >> 17) % 3, dv = (h >> 20) & 255, dk = d, b = bh >> 2, hh = bh & 3;
      float mm = 0.f, C = 0.f;
      for (int j = 0; j < c; ++j) {
        const int tok0 = b * SEQ + j * 64;
        float B = 0.f;
        for (int s = 0; s < 64; ++s) B += p.gates[(size_t)(tok0 + s) * 8 + 4 + hh];
        float bs = 0.f, ml = -INFINITY;
        for (int s = 0; s < 64; ++s) { bs += p.gates[(size_t)(tok0 + s) * 8 + 4 + hh]; ml = fmaxf(ml, B - bs + p.gates[(size_t)(tok0 + s) * 8 + hh]); }
        bs = 0.f; float u = 0.f;
        for (int s = 0; s < 64; ++s) {
          bs += p.gates[(size_t)(tok0 + s) * 8 + 4 + hh];
          u += expf(B - bs + p.gates[(size_t)(tok0 + s) * 8 + hh] - ml) * bf2f(p.proj[(size_t)(tok0 + s) * 2048 + 512 + hh * 128 + dk]) * bf2f(p.vt[((size_t)(bh * 256 + dv)) * SEQ + j * 64 + s]);
        }
        const float mn = fmaxf(B + mm, ml);
        C = expf(B + mm - mn) * C + expf(ml - mn) * u; mm = mn;
      }
      if (dbad(bf2f(p.uck[((size_t)((bh * 128 + c) * 256 + dv)) * 128 + dk]), C, 0.03f, 0.5f)) dfail(p, 39);
      if (bf2f(p.uck[((size_t)((bh * 128 + 0) * 256 + dv)) * 128 + dk]) != 0.f) dfail(p, 40);
    }
  } else if (ph == 9) {
    const int bh = h & 7, c = (h >> 3) & 127, t = (h >> 10) & 63, dvs = (h >> 16) & 255, b = bh >> 2, hh = bh & 3;
    const int tok0 = b * SEQ + c * 64, tk = tok0 + t;
    float* qk = (float*)dsm + tid * 64;
    const float mk = p.mk[bh * 129 + c];
    float bt = 0.f, G = -INFINITY;
    for (int s = 0; s <= t; ++s) {
      bt += p.gates[(size_t)(tok0 + s) * 8 + 4 + hh];
      const float g = p.gates[(size_t)(tok0 + s) * 8 + hh] - bt; G = fmaxf(G, g);
      float a = 0.f;
      for (int d = 0; d < 128; ++d) a += bf2f(p.proj[(size_t)tk * 2048 + hh * 128 + d]) * bf2f(p.proj[(size_t)(tok0 + s) * 2048 + 512 + hh * 128 + d]);
      qk[s] = a;
      qk[s] = a * 1.0f;
    }
    const float M = fmaxf(mk, G), wi = expf(mk - M), emt = expf(-(bt + M));
    { float b2 = 0.f; for (int s = 0; s <= t; ++s) { b2 += p.gates[(size_t)(tok0 + s) * 8 + 4 + hh]; qk[s] *= expf(p.gates[(size_t)(tok0 + s) * 8 + hh] - b2 - M); } }
    float den = 0.f;
    for (int s = 0; s <= t; ++s) den += qk[s];
    { float qn = 0.f; for (int d = 0; d < 128; ++d) qn += bf2f(p.proj[(size_t)tk * 2048 + hh * 128 + d]) * p.nk[(size_t)(bh * 128 + c) * 128 + d]; den += wi * qn; }
    const float inv = 1.f / fmaxf(fabsf(den), emt);
    float s1 = 0.f, s2 = 0.f, hs = 0.f;
    for (int dv = 0; dv < 256; ++dv) {
      float num = 0.f;
      for (int s = 0; s <= t; ++s) num += qk[s] * bf2f(p.vt[((size_t)(bh * 256 + dv)) * SEQ + c * 64 + s]);
      float qc = 0.f;
      for (int d = 0; d < 128; ++d) qc += bf2f(p.proj[(size_t)tk * 2048 + hh * 128 + d]) * bf2f(p.uck[((size_t)((bh * 128 + c) * 256 + dv)) * 128 + d]);
      const float hv = (num + wi * qc) * inv;
      s1 += hv; s2 += hv * hv; if (dv == dvs) hs = hv;
    }
    const float mu = s1 / 256.f, var = s2 / 256.f - mu * mu;
    const float o = ddot(p.H + (size_t)tk * D, p.in[I_MLWIN] + 2048 + hh * 256 + dvs, 3080, 1024);
    const float want = (hs - mu) * rsqrtf(var + LN_EPS) * p.in[I_MLNW][hh * 256 + dvs] / (1.f + expf(-o));
    if (dbad(bf2f(p.proj[(size_t)tk * 2048 + 1024 + hh * 256 + dvs]), want, 0.05f, 1.0f)) dfail(p, 10);
  } else if (ph == 18) {
    const int col = (h >> 12) % 1024, d = col & 63;
    float v = ddot(p.H + (size_t)tok * D, p.in[I_ATTWQ] + col, 1024, 1024);
    if (d < 16) {
      const int pcol = d < 8 ? col + 8 : col - 8;
      const float v2 = ddot(p.H + (size_t)tok * D, p.in[I_ATTWQ] + pcol, 1024, 1024);
      const float ang = (float)((double)pos_of(tok) * p.inv_freq[d & 7]);
      v = d < 8 ? v * cosf(ang) - v2 * sinf(ang) : v * cosf(ang) + v2 * sinf(ang);
    }
    if (dbad(bf2f(p.q[(size_t)tok * D + col]), v * 0.125f, 0.03f, 0.2f)) dfail(p, 19);
  } else if (ph == 19) {
    const int qh = (h >> 12) & 15, d = (h >> 16) & 63, kvh = qh >> 2;
    const float sink = p.in[I_SINKS][qh];
    const bf16* qp = p.q + (size_t)tok * D + qh * 64;
    float mx = sink, want;
    if (tok < TP) {
      const int b = tok >> 13, pos = tok & 8191;
      for (int pass = 0; pass < 2; ++pass) {
        float sum = 0.f, o = 0.f;
        for (int kp = pos - 127; kp <= pos; ++kp) {
          if (kp < 0) continue;
          float a = 0.f;
          for (int e = 0; e < 64; ++e) a += bf2f(qp[e]) * bf2f(p.ks[(size_t)(b * SEQ + kp) * 256 + kvh * 64 + e]);
          if (pass == 0) mx = fmaxf(mx, a);
          else { const float w = expf(a - mx); sum += w; o += w * bf2f(p.vta[((size_t)((b * 4 + kvh) * 64 + d)) * SEQ + kp]); }
        }
        want = o / (sum + expf(sink - mx));
      }
    } else {
      const int b = (tok - TP) >> 2, t = (tok - TP) & 3;
      for (int pass = 0; pass < 2; ++pass) {
        float sum = 0.f, o = 0.f;
        for (int key = 0; key < 132; ++key) {
          const bool valid = key < 128 ? (key > t) : ((key - 128) <= t);
          if (!valid) continue;
          const float* kp = key < 128 ? p.in[I_CK] + ((size_t)(b * 128 + key) * 4 + kvh) * 64 : p.out + O_WKS + ((size_t)(b * 128 + 124 + key - 128) * 4 + kvh) * 64;
          const float* vp = key < 128 ? p.in[I_CV] + ((size_t)(b * 128 + key) * 4 + kvh) * 64 : p.out + O_WVS + ((size_t)(b * 128 + 124 + key - 128) * 4 + kvh) * 64;
          float a = 0.f;
          for (int e = 0; e < 64; ++e) a += bf2f(qp[e]) * kp[e];
          if (pass == 0) mx = fmaxf(mx, a);
          else { const float w = expf(a - mx); sum += w; o += w * vp[d]; }
        }
        want = o / (sum + expf(sink - mx));
      }
    }
    if (dbad(bf2f(p.att[(size_t)tok * D + qh * 64 + d]), want, 0.03f, 0.3f)) dfail(p, 20);
  }
}
#endif

#define XB_TMO      128
#define XB_XCNT(j)  (256  + 64 * (j))
#define XB_XSUB(j)  (1280 + 64 * (j))
#define XB_XGEN(j)  (2304 + 64 * (j))
#define XB_TOP      3328
#define XB_TOPGEN   3392
#define XCD_BAR_WORDS 3456
#define XB_SPIN_CAP (1u << 18)
__device__ __forceinline__ unsigned xb_ld(unsigned* p)              { return __hip_atomic_load(p, __ATOMIC_RELAXED, __HIP_MEMORY_SCOPE_AGENT); }
__device__ __forceinline__ unsigned xb_add(unsigned* p, unsigned v) { return __hip_atomic_fetch_add(p, v, __ATOMIC_RELAXED, __HIP_MEMORY_SCOPE_AGENT); }
__device__ __forceinline__ unsigned xb_xcc_id() { return (unsigned)__builtin_amdgcn_s_getreg((3 << 11) | 20) & 0xFu; }
#define XB_SPIN(cond, bar) do { unsigned _sp = 0; while (cond) { __builtin_amdgcn_s_sleep(1); \
    if ((++_sp & 255u) == 0u) { if (xb_ld(&(bar)[XB_TMO])) break; if (_sp > XB_SPIN_CAP) { atomicAdd(&(bar)[XB_TMO], 1u); break; } } } } while (0)
struct XcdBarrier { unsigned* bar; unsigned x; volatile LAS unsigned* st; };
__device__ __forceinline__ XcdBarrier xcd_barrier_post(unsigned* bar, volatile LAS unsigned* st) {
  XcdBarrier b; b.bar = bar; b.x = xb_xcc_id(); b.st = st;
  if (threadIdx.x == 0) (void)xb_add(&bar[XB_XCNT(b.x)], 1u);
  return b;
}
__device__ __forceinline__ void xcd_barrier_complete(unsigned* bar, unsigned x, unsigned& nloc, unsigned& nx) {
  const unsigned G = gridDim.x * gridDim.y * gridDim.z;
  unsigned sum, cnt, mine, sp = 0u;
  for (;;) {
    sum = 0u; cnt = 0u; mine = 0u;
#pragma unroll
    for (unsigned j = 0; j < 16; ++j) { const unsigned c = xb_ld(&bar[XB_XCNT(j)]); sum += c; cnt += (c > 0u) ? 1u : 0u; mine = (j == x) ? c : mine; }
    if (sum == G) break;
    __builtin_amdgcn_s_sleep(1);
    if ((++sp & 255u) == 0u) { if (xb_ld(&bar[XB_TMO])) break; if (sp > XB_SPIN_CAP) { atomicAdd(&bar[XB_TMO], 1u); break; } }
  }
  nloc = mine > 0u ? mine : 1u; nx = cnt > 0u ? cnt : 1u;
}
__device__ __forceinline__ void xcd_barrier(const XcdBarrier& b) {
  asm volatile("s_waitcnt vmcnt(0)" ::: "memory");
  __syncthreads();
  if (threadIdx.x == 0) {
    unsigned* bar = b.bar;
    __builtin_amdgcn_s_waitcnt(0);
    unsigned nloc = b.st[0], nx = b.st[1];
    if (nloc == 0u) { xcd_barrier_complete(bar, b.x, nloc, nx); b.st[0] = nloc; b.st[1] = nx; }
    const unsigned old = xb_add(&bar[XB_XSUB(b.x)], 1u);
    const unsigned gen = old / nloc;
    if (old + 1u == (gen + 1u) * nloc) {
      __builtin_amdgcn_fence(__ATOMIC_RELEASE, "agent");
      asm volatile("s_waitcnt vmcnt(0)" ::: "memory");
      const unsigned og = xb_add(&bar[XB_TOP], 1u);
      const unsigned tg = og / nx;
      if (og + 1u == (tg + 1u) * nx) xb_add(&bar[XB_TOPGEN], 1u);
      else XB_SPIN(xb_ld(&bar[XB_TOPGEN]) == tg, bar);
      __builtin_amdgcn_fence(__ATOMIC_ACQUIRE, "agent");
      xb_add(&bar[XB_XGEN(b.x)], 1u);
      asm volatile("s_waitcnt vmcnt(0)" ::: "memory");
    } else {
      XB_SPIN(xb_ld(&bar[XB_XGEN(b.x)]) == gen, bar);
      __builtin_amdgcn_fence(__ATOMIC_ACQUIRE, "agent");
      asm volatile("s_waitcnt vmcnt(0)" ::: "memory");
    }
  }
  __syncthreads();
}

__global__ void __launch_bounds__(NTHR, 2) yoco_megakernel(Params p_unused) {
  cg::grid_group grid = cg::this_grid();
  __shared__ __attribute__((aligned(16))) char smem[LDS_BYTES];
  __shared__ uint4 xb_words;
  const __attribute__((address_space(4))) Params* pbase0 = (const __attribute__((address_space(4))) Params*)__builtin_amdgcn_kernarg_segment_ptr();
  unsigned* barw = pbase0->bar;
  if (threadIdx.x == 0) xb_words = make_uint4(0u, 0u, 0u, 0u);
  if (blockIdx.x == 0) for (int i = threadIdx.x; i < XCD_BAR_WORDS; i += NTHR) barw[i] = 0u;
  __syncthreads();
  XcdBarrier xb; xb.bar = barw; xb.x = 0u; xb.st = (volatile LAS unsigned*)&xb_words;
  bool posted = false;
  enum { K_PREP = 0, K_ADA, K_LN, K_UP, K_RES, K_MLIN, K_MLA, K_SCAN, K_MLC, K_Q, K_ATT };
  constexpr int NPH = 25;
  const __attribute__((address_space(4))) Params* pbase = (const __attribute__((address_space(4))) Params*)__builtin_amdgcn_kernarg_segment_ptr();
#pragma unroll 1
  for (int step = 0; step < NPH * PROBE_REP; ++step) {
    const int ph = step / PROBE_REP;
    const bool dry = (PROBE_REP == 2) && ((step & 1) == 0);
    if (dry && !((PROBE_MASK >> ph) & 1)) continue;
    const __attribute__((address_space(4))) Params* pp = pbase;
    asm volatile("" : "+s"(pp));
    PRef p = *pp;
    int kind = K_LN;
    int layer = ph >= 15 ? 1 : 0;
    const int lo = layer * 9216;
    int ffn = 0;
    int res_kind = 0;
    LnArgs la = LnArgs{0, layer, 0, -1, -1, 0, 0, 0, 0.f, 0};
    switch (ph) {
      case 0: kind = K_PREP; break;
      case 1: kind = K_ADA; break;
      case 2: la = LnArgs{1, 0, 0, 0, -1, 0, 0, 0, 0.f, 0}; break;
      case 3: case 15: kind = K_UP; ffn = 0; break;
      case 4: case 16: kind = K_RES; ffn = 0; break;
      case 5: la = LnArgs{0, 0, 0, 3 * 1024, -1, 1, 0, 0, 0.f, 0}; break;
      case 17: la = LnArgs{0, 1, 0, 9216 + 3 * 1024, -1, 0, 0, 0, 0.f, 0}; break;
      case 6: kind = K_MLIN; break;
      case 7: kind = K_MLA; break;
      case 8: kind = K_SCAN; break;
      case 9: kind = K_MLC; break;
      case 10: case 20: kind = K_RES; res_kind = 1; break;
      case 11: la = LnArgs{0, 0, 1, 6 * 1024, -1, 0, 0, 0, 0.f, 0}; break;
      case 21: la = LnArgs{0, 1, 1, 9216 + 6 * 1024, -1, 0, 0, 0, 0.f, 0}; break;
      case 12: case 22: kind = K_UP; ffn = 1; break;
      case 13: case 23: kind = K_RES; ffn = 1; break;
      case 14: la = LnArgs{0, 0, 2, 9216, 18432, 0, 0, 0, 0.f, 0}; break;
      case 18: kind = K_Q; break;
      case 19: kind = K_ATT; break;
      case 24: la = LnArgs{0, 1, 2, -1, -1, 0, 0, 0, 0.f, 0}; break;
      default: break;
    }
    if (ph == 5) la.xfirst = 1;
    if (ph == 5 || ph == 17) { la.nsl = 11; la.pgoff = lo + 2 * 1024; la.pwgt = 0.5f; }
    if (ph == 14 || ph == 24) { la.nsl = 11; la.pgoff = lo + 8 * 1024; la.pwgt = 0.5f; }
    if (ph == 11 || ph == 21) { la.nsl = 4; la.pgoff = lo + 5 * 1024; la.pwgt = 1.0f; }
    switch (kind) {
      case K_PREP: phase_prep(p, smem, 0); break;
      case K_ADA: {
        GArgs g = GArgs{p.cact, 1024, p.wt_ada, 1024, 256, MODW, 0, 0.f, ALPHA, 1024, 0, 0, p.out};
        gemm_phase<M_ADA>(p, g, smem);
        phase_prep(p, smem, 1);
      } break;
      case K_LN: if (dry) la.src_input = 2; ln_phase(p, la, smem); break;
      case K_UP: {
        const int wi = layer * 2 + ffn;
        const bf16* w = wi == 0 ? p.wt_up[0] : wi == 1 ? p.wt_up[1] : wi == 2 ? p.wt_up[2] : p.wt_up[3];
        GArgs g = GArgs{p.H, 1024, w, 1024, T, 2 * F, 0, 0.f, ALPHA, 1024, 0, 0, p.out};
        gemm_phase<M_SWIGLU>(p, g, smem);
        if (ph == 15) {
          GArgs g2 = GArgs{p.hkv, 1024, p.wt_kv, 1024, T, 512, 0, 0.f, ALPHA, 1024, opq_gdim(), opq_gdim() - 1 - opq_bid(), p.out};
          gemm_phase<M_KV>(p, g2, smem);
        }
      } break;
      case K_RES: {
        GArgs g;
        if (res_kind == 0) {
          const int wi = layer * 2 + ffn;
          const bf16* w = wi == 0 ? p.wt_down[0] : wi == 1 ? p.wt_down[1] : wi == 2 ? p.wt_down[2] : p.wt_down[3];
          g = GArgs{p.hid, F, w, F, T, 1024, lo + (ffn ? 8 : 2) * 1024, 0.5f, ALPHA, F, 0, 0, p.out};
        } else if (layer == 0) {
          g = GArgs{p.H, 1024, p.wt_mlout, 1024, T, 1024, lo + 5 * 1024, 1.0f, ALPHA, 1024, 0, 0, p.out};
        } else {
          g = GArgs{p.att, 1024, p.wt_o, 1024, T, 1024, lo + 5 * 1024, 1.0f, ALPHA, 1024, 0, 0, p.out};
        }
        if (ph == 4) g.xsrc = p.in[I_XP];
        if (dry) { g.alpha = 1.0f; g.wgt = 0.0f; g.xsrc = p.out; }
        g.M = TP;
        gemm_phase<M_RES>(p, g, smem);
        {
          const int nsl = g.K / 256, bid = opq_bid();
          if (bid < 8 * nsl) {
            const int sl = bid >> 3;
            GArgs g2 = GArgs{g.A + (size_t)TP * g.lda + sl * 256, g.lda, g.Bt + sl * 256, 256, 512, 1024, sl, 0.f, 0.f, g.K, 8, bid & 7, p.out};
            gemm_phase<M_PART>(p, g2, smem);
          }
        }
      } break;
      case K_MLIN: {
        GArgs g = GArgs{p.H, 1024, p.wt_mlin, 1024, TP, 3072, 0, 0.f, ALPHA, 1024, 0, 0, p.out};
        gemm_phase<M_MLIN>(p, g, smem);
        {
          const int bid = opq_bid();
          if (bid < 96) {
            const int sl = bid / 24;
            GArgs g2 = GArgs{p.H + (size_t)TP * 1024 + sl * 256, 1024, p.wt_mlin + sl * 256, 256, 512, 3072, sl, 0.f, 0.f, 1024, 24, bid % 24, p.out};
            gemm_phase<M_PART>(p, g2, smem);
          }
        }
      } break;
      case K_MLA:
        for (int it = vq_bid(); it < 1024; it += vq_gdim()) mlstm_A_item(p, it, smem + vq_vb() * VLDS);
        if (vq_gdim() != 512) for (int it = vq_bid(); it < 512; it += vq_gdim()) mlstm_sample_item(p, it, smem + vq_vb() * VLDS, dry);
        break;
      case K_SCAN:
        if (vq_gdim() == 512 && vq_bid() >= 256) { for (int it = vq_bid() - 256; it < 512; it += 256) mlstm_sample_item(p, it, smem + vq_vb() * VLDS, dry); }
        else mlstm_scan_phase(p, smem + vq_vb() * VLDS, dry);
        break;
      case K_MLC:
        for (int it = vq_bid(); it < 1024; it += vq_gdim()) mlstm_C_item(p, it, smem + vq_vb() * VLDS, dry);
        break;
      case K_Q: {
        GArgs g = GArgs{p.H, 1024, p.wt_q, 1024, TP, 1024, 0, 0.f, ALPHA, 1024, 0, 0, p.out};
        gemm_phase<M_Q>(p, g, smem);
        {
          const int bid = opq_bid();
          if (bid < 32) {
            const int sl = bid >> 3;
            GArgs g2 = GArgs{p.H + (size_t)TP * 1024 + sl * 256, 1024, p.wt_q + sl * 256, 256, 512, 1024, sl, 0.f, 0.f, 1024, 8, bid & 7, p.out};
            gemm_phase<M_PART>(p, g2, smem);
          }
        }
      } break;
      case K_ATT:
        for (int it = vq_bid(); it < 512; it += vq_gdim()) attn_prompt_item(p, it, smem + vq_vb() * VLDS);
        for (int it = vq_bid(); it < 512; it += vq_gdim()) attn_sample_item(p, it, smem + vq_vb() * VLDS);
        break;
      default: break;
    }
#ifdef SELFCHECK
    grid.sync();
    if (blockIdx.x == 0) {
      if (ph == 0 && threadIdx.x == 0) *p.dbg = 1000;
      __syncthreads();
      selfcheck(p, ph, smem);
    }
    grid.sync();
    if (ph + 1 == NPH && blockIdx.x == 0 && threadIdx.x == 0) {
      const int code = *p.dbg;
      if (code != 1000) p.out[0] = 1e4f * exp10f(0.4f * (float)code);
    }
#else
    if (step + 1 < NPH * PROBE_REP) {
      if (!posted) {
        grid.sync();
        xb = xcd_barrier_post(barw, (volatile LAS unsigned*)&xb_words);
        posted = true;
      } else { xcd_barrier(xb); if (PROBE_SYNC2) xcd_barrier(xb); }
    }
#endif
  }
}

extern "C" void kernel_launch(void* const* d_in, const int* in_sizes, int n_in, void* d_out, int out_size, void* d_ws, size_t ws_size, hipStream_t stream) {
  Params p;
  std::memset((void*)&p, 0, sizeof(p));
  for (int i = 0; i < 27; ++i) p.in[i] = (const float*)d_in[i];
  p.out = (float*)d_out;
  char* ws = (char*)d_ws;
  size_t off = 0;
  auto alloc = [&](size_t bytes) { char* r = ws + off; off += (bytes + 255) & ~(size_t)255; return r; };
  p.wt_ada = (bf16*)alloc((size_t)MODW * 1024 * 2);
  for (int i = 0; i < 4; ++i) p.wt_up[i] = (bf16*)alloc((size_t)5632 * 1024 * 2);
  for (int i = 0; i < 4; ++i) p.wt_down[i] = (bf16*)alloc((size_t)1024 * F * 2);
  p.wt_mlin = (bf16*)alloc((size_t)3072 * 1024 * 2);
  p.wt_mlout = (bf16*)alloc((size_t)1024 * 1024 * 2);
  p.wt_kv = (bf16*)alloc((size_t)512 * 1024 * 2);
  p.wt_q = (bf16*)alloc((size_t)1024 * 1024 * 2);
  p.wt_o = (bf16*)alloc((size_t)1024 * 1024 * 2);
  p.cact = (bf16*)alloc((size_t)256 * 1024 * 2);
  p.mods = (float*)alloc((size_t)NBR * MODW * 4);
  p.rot = (float2*)alloc((size_t)8196 * 8 * 8);
  p.H = (bf16*)alloc((size_t)T * 1024 * 2);
  p.gates = (float*)alloc((size_t)T * 8 * 4);
  char* arena = ws + off;
  size_t aoff = 0;
  auto aalloc = [&](size_t bytes) { char* r = arena + aoff; aoff += (bytes + 255) & ~(size_t)255; return r; };
  p.hid = (bf16*)arena;
  p.proj = (bf16*)aalloc((size_t)T * 2048 * 2);
  p.q = (bf16*)arena;
  p.att = (bf16*)(arena + (size_t)T * 1024 * 2);
  p.kt = (bf16*)aalloc((size_t)8 * 128 * SEQ * 2);
  p.vt = (bf16*)aalloc((size_t)8 * 256 * SEQ * 2);
  p.hkv = (bf16*)aalloc((size_t)T * 1024 * 2);
  p.ks = (bf16*)aalloc((size_t)T * 256 * 2);
  p.vta = (bf16*)aalloc((size_t)8 * 64 * SEQ * 2);
  size_t save = aoff;
  aoff = (size_t)((char*)p.hkv - arena);
  p.uck = (bf16*)aalloc((size_t)8 * 128 * 256 * 128 * 2);
  if (aoff < save) aoff = save;
  p.vsamp = (bf16*)aalloc((size_t)512 * 1024 * 2);
  p.un = (float*)aalloc((size_t)8 * 128 * 128 * 4);
  p.nk = (float*)aalloc((size_t)8 * 128 * 128 * 4);
  p.ab = (float*)aalloc((size_t)8 * 128 * 2 * 4);
  p.mk = (float*)aalloc((size_t)8 * 129 * 4);
  p.bar = (unsigned*)aalloc(XCD_BAR_WORDS * 4);
  p.part = (float*)aalloc((size_t)4 * 512 * 3072 * 4);
  p.dbg = (int*)aalloc(256);
  p.stash = (float*)aalloc(4096);
  int ts = 0, wi = 0;
  auto addw = [&](const float* src, bf16* dst, int K, int N, int ld, int mode) {
    p.wd[wi].src = src; p.wd[wi].dst = dst; p.wd[wi].K = K; p.wd[wi].N = N; p.wd[wi].ld = ld; p.wd[wi].tstart = ts; p.wd[wi].mode = mode;
    ts += (K / 64) * (N / 64); ++wi;
  };
  const float* const* in = (const float* const*)d_in;
  addw(in[I_ADAW], p.wt_ada, 1024, 9216, 9216, 0);
  addw(in[I_ADAW] + (size_t)1024 * 9216, p.wt_ada + (size_t)9216 * 1024, 1024, 9216, 9216, 0);
  addw(in[I_KVADAW], p.wt_ada + (size_t)18432 * 1024, 1024, 2048, 2048, 0);
  for (int l = 0; l < 2; ++l) {
    addw(in[I_F1U] + (size_t)l * 1024 * 5632, p.wt_up[l * 2 + 0], 1024, 5632, 5632, 1 | (l ? 2 : 0));
    addw(in[I_F2U] + (size_t)l * 1024 * 5632, p.wt_up[l * 2 + 1], 1024, 5632, 5632, 1 | (l ? 2 : 0));
    addw(in[I_F1D] + (size_t)l * F * 1024, p.wt_down[l * 2 + 0], F, 1024, 1024, (l ? 2 : 0));
    addw(in[I_F2D] + (size_t)l * F * 1024, p.wt_down[l * 2 + 1], F, 1024, 1024, (l ? 2 : 0));
  }
  addw(in[I_MLWIN], p.wt_mlin, 1024, 1024, 3080, 0);
  addw(in[I_MLWIN] + 2048, p.wt_mlin + (size_t)1024 * 1024, 1024, 1024, 3080, 0);
  addw(in[I_MLWIN] + 1024, p.wt_mlin + (size_t)2048 * 1024, 1024, 1024, 3080, 0);
  addw(in[I_MLWOUT], p.wt_mlout, 1024, 1024, 1024, 0);
  addw(in[I_KVW], p.wt_kv, 1024, 512, 512, 2);
  addw(in[I_ATTWQ], p.wt_q, 1024, 1024, 1024, 2);
  addw(in[I_ATTWO], p.wt_o, 1024, 1024, 1024, 2);
  p.wd_total = ts;
  for (; wi < 20; ++wi) p.wd[wi].tstart = 0x7fffffff;
  for (int i = 0; i < 8; ++i) p.inv_freq[i] = pow(500000.0, -(double)i / 8.0);

  static int grid_blocks = 0;
  if (!grid_blocks) {
    int dev = 0, cus = 0, per_cu = 0;
    (void)hipGetDevice(&dev);
    (void)hipDeviceGetAttribute(&cus, hipDeviceAttributeMultiprocessorCount, dev);
    (void)hipOccupancyMaxActiveBlocksPerMultiprocessor(&per_cu, yoco_megakernel, NTHR, 0);
    if (per_cu > 1) per_cu = 1;
    if (per_cu < 1) per_cu = 1;
    grid_blocks = cus * per_cu;
    grid_blocks &= ~7;
  }
  void* args[] = {&p};
  hipError_t e = hipLaunchCooperativeKernel((void*)yoco_megakernel, dim3(grid_blocks), dim3(NTHR), args, 0, stream);
  if (e != hipSuccess) fprintf(stderr, "cooperative launch failed: %s (grid %d)\n", hipGetErrorString(e), grid_blocks);
}
```

```cpp
#include <hip/hip_runtime.h>
#include <hip/hip_cooperative_groups.h>
#include <cstdio>
#include <cstdint>
#include <cmath>
#include <cstring>
namespace cg = cooperative_groups;

typedef unsigned short bf16;
typedef __attribute__((ext_vector_type(8))) short bf16x8;
typedef __attribute__((ext_vector_type(4))) float f32x4;
typedef __attribute__((ext_vector_type(4))) unsigned u32x4;

constexpr int D = 1024, T = 16896, TP = 16384, SEQ = 8192, F = 2816;
constexpr int NBR = 130;
constexpr int MODW = 20480;
constexpr float ALPHA = 1.4142135623730951f;
constexpr float LN_EPS = 1e-5f;
#ifndef PROBE_REP
#define PROBE_REP 1
#define PROBE_MASK 0
#endif
#ifndef PROBE_SYNC2
#define PROBE_SYNC2 0
#endif
constexpr int NTHR = 512;
constexpr int LDS_BYTES = 131072;
constexpr int VLDS = 32768;

constexpr size_t O_Y = 0;
constexpr size_t O_CP = 17301504;
constexpr size_t O_NP = 17563648;
constexpr size_t O_MP = 17564672;
constexpr size_t O_WKP = 17564680;
constexpr size_t O_WVP = 17630216;
constexpr size_t O_CS = 17695752;
constexpr size_t O_NS = 34472968;
constexpr size_t O_MS = 34538504;
constexpr size_t O_WKS = 34539016;
constexpr size_t O_WVS = 38733320;

struct Params;
struct WDesc { const float* src; bf16* dst; int K, N, ld, tstart, mode, pad; };

struct Params {
  const float* in[27];
  float* out;
  WDesc wd[20];
  int wd_total; int pad0;
  bf16 *wt_ada, *wt_up[4], *wt_down[4], *wt_mlin, *wt_mlout, *wt_kv, *wt_q, *wt_o;
  bf16* cact; float* mods; float2* rot; bf16* H; float* gates;
  bf16 *hid, *proj, *kt, *vt, *uck, *vsamp;
  float *un, *ab, *nk, *mk;
  bf16 *hkv, *ks, *vta, *q, *att;
  int* dbg; float* stash; unsigned* bar; float* part;
  double inv_freq[8];
};

typedef const __attribute__((address_space(4))) Params& PRef;

enum { I_XP = 0, I_XS, I_CP, I_CS, I_STC, I_STN, I_STM, I_CK, I_CV, I_ADAW, I_ADAB, I_F1U, I_F1D, I_F2U, I_F2D, I_LNG, I_LNB,
       I_MLWIN, I_MLBG, I_MLNW, I_MLWOUT, I_KVADAW, I_KVADAB, I_KVW, I_ATTWQ, I_SINKS, I_ATTWO };

__device__ __forceinline__ bf16 f2bf(float f) {
  unsigned u = __float_as_uint(f);
  u += 0x7fffu + ((u >> 16) & 1u);
  return (bf16)(u >> 16);
}
__device__ __forceinline__ float bf2f(bf16 h) { return __uint_as_float(((unsigned)h) << 16); }
__device__ __forceinline__ unsigned pack2(float a, float b) { return (unsigned)f2bf(a) | ((unsigned)f2bf(b) << 16); }
__device__ __forceinline__ int brow_of(int tok) { return tok < TP ? (tok >> 13) : 2 + ((tok - TP) >> 2); }
__device__ __forceinline__ int pos_of(int tok) { return tok < TP ? (tok & 8191) : 8192 + ((tok - TP) & 3); }
__device__ __forceinline__ float wave_sum(float v) {
#pragma unroll
  for (int o = 32; o > 0; o >>= 1) v += __shfl_xor(v, o);
  return v;
}
__device__ __forceinline__ float wave_max(float v) {
#pragma unroll
  for (int o = 32; o > 0; o >>= 1) v = fmaxf(v, __shfl_xor(v, o));
  return v;
}
__device__ __forceinline__ float scan_add(float x, int lane) {
#pragma unroll
  for (int o = 1; o < 64; o <<= 1) { float y = __shfl_up(x, o); if (lane >= o) x += y; }
  return x;
}
__device__ __forceinline__ float scan_max(float x, int lane) {
#pragma unroll
  for (int o = 1; o < 64; o <<= 1) { float y = __shfl_up(x, o); if (lane >= o) x = fmaxf(x, y); }
  return x;
}
__device__ __forceinline__ float sigmoidf_(float x) { return 1.f / (1.f + __expf(-x)); }
__device__ __forceinline__ int opq_tid() { int t = threadIdx.x; asm volatile("" : "+v"(t)); return t; }
__device__ __forceinline__ int opq_bid() { int t = blockIdx.x; asm volatile("" : "+s"(t)); return t; }
__device__ __forceinline__ int opq_gdim() { int t = gridDim.x; asm volatile("" : "+s"(t)); return t; }
__device__ __forceinline__ int vq_tid() { return opq_tid() & 255; }
__device__ __forceinline__ int vq_vb() { return __builtin_amdgcn_readfirstlane(opq_tid() >> 8); }
__device__ __forceinline__ int vq_bid() { return opq_bid() * 2 + vq_vb(); }
__device__ __forceinline__ int vq_gdim() { return opq_gdim() * 2; }
__device__ __forceinline__ float4 ldnt4(const float* q) { const f32x4 v = __builtin_nontemporal_load((const f32x4*)q); return make_float4(v[0], v[1], v[2], v[3]); }
#define MFMA(a, b, c) __builtin_amdgcn_mfma_f32_16x16x32_bf16(a, b, c, 0, 0, 0)

struct WInfo { const float* src; bf16* dst; int K, ld, mode, k0, n0; };
__device__ __forceinline__ WInfo prep_lookup(PRef p, int t) {
  WDesc w;
  w.src = p.wd[0].src; w.dst = p.wd[0].dst; w.K = p.wd[0].K; w.N = p.wd[0].N; w.ld = p.wd[0].ld; w.tstart = p.wd[0].tstart; w.mode = p.wd[0].mode;
#pragma unroll
  for (int i = 1; i < 20; ++i) if (t >= p.wd[i].tstart) { w.src = p.wd[i].src; w.dst = p.wd[i].dst; w.K = p.wd[i].K; w.N = p.wd[i].N; w.ld = p.wd[i].ld; w.tstart = p.wd[i].tstart; w.mode = p.wd[i].mode; }
  const int lt = t - w.tstart, nnt = w.N >> 6;
  WInfo r; r.src = w.src; r.dst = w.dst; r.K = w.K; r.ld = w.ld; r.mode = w.mode; r.n0 = (lt % nnt) * 64; r.k0 = (lt / nnt) * 64;
  return r;
}
__device__ __forceinline__ void phase_prep(PRef p, char* smem) {
  const int tid = vq_tid();
  float* tile = (float*)(smem + vq_vb() * VLDS);
  const int vbid = vq_bid(), vg = vq_gdim(), total = p.wd_total;
  const int kr = tid >> 4, nc = (tid & 15) * 4;
#define PREP_LOAD(R, W, ACT) do { if (ACT) { const float* sp = (W).src + (size_t)((W).k0 + kr) * (W).ld + (W).n0 + nc; \
    (R##0) = ldnt4(sp); (R##1) = ldnt4(sp + (size_t)16 * (W).ld); (R##2) = ldnt4(sp + (size_t)32 * (W).ld); (R##3) = ldnt4(sp + (size_t)48 * (W).ld); } } while (0)
#define PREP_TOLDS(R, ACT) do { if (ACT) { float* tp = tile + kr * 65 + nc; \
    tp[0] = (R##0).x; tp[1] = (R##0).y; tp[2] = (R##0).z; tp[3] = (R##0).w; \
    tp[16 * 65 + 0] = (R##1).x; tp[16 * 65 + 1] = (R##1).y; tp[16 * 65 + 2] = (R##1).z; tp[16 * 65 + 3] = (R##1).w; \
    tp[32 * 65 + 0] = (R##2).x; tp[32 * 65 + 1] = (R##2).y; tp[32 * 65 + 2] = (R##2).z; tp[32 * 65 + 3] = (R##2).w; \
    tp[48 * 65 + 0] = (R##3).x; tp[48 * 65 + 1] = (R##3).y; tp[48 * 65 + 2] = (R##3).z; tp[48 * 65 + 3] = (R##3).w; } } while (0)
#define PREP_STORE(W, ACT) do { if (ACT) { _Pragma("unroll") for (int i = 0; i < 2; ++i) { \
      int id = tid + i * 256; int n = id >> 3, kc = (id & 7) * 8; uint4 o; \
      o.x = pack2(tile[(kc + 0) * 65 + n], tile[(kc + 1) * 65 + n]); o.y = pack2(tile[(kc + 2) * 65 + n], tile[(kc + 3) * 65 + n]); \
      o.z = pack2(tile[(kc + 4) * 65 + n], tile[(kc + 5) * 65 + n]); o.w = pack2(tile[(kc + 6) * 65 + n], tile[(kc + 7) * 65 + n]); \
      int gn = (W).n0 + n; \
      if ((W).mode & 1) { const int isu = gn >= F; const int j = isu ? gn - F : gn; gn = (j >> 7) * 256 + ((j >> 2) & 1) * 128 + ((j >> 5) & 3) * 32 + isu * 16 + ((j >> 3) & 3) * 4 + (j & 3); } \
      if ((W).mode & 2) __builtin_nontemporal_store((u32x4){o.x, o.y, o.z, o.w}, (u32x4*)((W).dst + (size_t)gn * (W).K + (W).k0 + kc)); \
      else *(uint4*)((W).dst + (size_t)gn * (W).K + (W).k0 + kc) = o; } } } while (0)
  float4 ra0, ra1, ra2, ra3, rb0, rb1, rb2, rb3;
  ra0 = ra1 = ra2 = ra3 = rb0 = rb1 = rb2 = rb3 = make_float4(0.f, 0.f, 0.f, 0.f);
  int ta = vbid, tb = vbid + vg;
  bool acta = ta < total, actb = tb < total;
  WInfo wa = prep_lookup(p, acta ? ta : 0), wb = prep_lookup(p, actb ? tb : 0);
  PREP_LOAD(ra, wa, acta);
  PREP_LOAD(rb, wb, actb);
  for (int t0 = 0; t0 < total; t0 += 2 * vg) {
    PREP_TOLDS(ra, acta);
    __syncthreads();
    const WInfo wa_cur = wa; const bool acta_cur = acta;
    ta += 2 * vg; acta = ta < total; wa = prep_lookup(p, acta ? ta : 0);
    PREP_LOAD(ra, wa, acta);
    PREP_STORE(wa_cur, acta_cur);
    __syncthreads();
    PREP_TOLDS(rb, actb);
    __syncthreads();
    const WInfo wb_cur = wb; const bool actb_cur = actb;
    tb += 2 * vg; actb = tb < total; wb = prep_lookup(p, actb ? tb : 0);
    PREP_LOAD(rb, wb, actb);
    PREP_STORE(wb_cur, actb_cur);
    __syncthreads();
  }
#undef PREP_LOAD
#undef PREP_TOLDS
#undef PREP_STORE
  const int gt = opq_bid() * NTHR + opq_tid(), gs = opq_gdim() * NTHR;
  for (int i = gt; i < 256 * 1024; i += gs) {
    int r = i >> 10, c = i & 1023;
    float v = 0.f;
    if (r < 2) v = p.in[I_CP][r * 1024 + c]; else if (r < NBR) v = p.in[I_CS][(r - 2) * 1024 + c];
    v = v / (1.f + expf(-v));
    p.cact[i] = (r < NBR) ? f2bf(v) : (bf16)0;
  }
  for (int i = gt; i < 8196 * 8; i += gs) {
    int pos = i >> 3, fi = i & 7;
    double ang = (double)pos * p.inv_freq[fi];
    const double TWO_PI_HI = 6.283185307179586232, TWO_PI_LO = 2.449293598294706414e-16;
    double k = rint(ang * 0.15915494309189533577);
    double r = fma(-k, TWO_PI_HI, ang); r = fma(-k, TWO_PI_LO, r);
    double r2 = r * r;
    double s = 1.0, c = 1.0;
#pragma unroll 1
    for (int n = 14; n >= 1; --n) {
      s = 1.0 - s * r2 / (double)((2 * n) * (2 * n + 1));
      c = 1.0 - c * r2 / (double)((2 * n - 1) * (2 * n));
    }
    s *= r;
    p.rot[i] = make_float2((float)c, (float)s);
  }
}

enum { M_ADA = 0, M_SWIGLU, M_RES, M_MLIN, M_KV, M_Q, M_PART };
struct GArgs { const bf16* A; int lda; const bf16* Bt; int K; int M, N; int goff; float wgt; float alpha; int ldb, uG, ucid; const float* xsrc; };
#define LAS __attribute__((address_space(3)))
constexpr int G_BM = 256, G_BK = 64, G_HALF = 128, G_HTB = G_HALF * G_BK * 2;
__device__ __forceinline__ int lds_byte(int r, int c) { const int st = (r >> 4) * 2 + (c >> 5), rr = r & 15, cc = c & 31, ob = rr * 64 + cc * 2; return st * 1024 + (ob ^ (((ob >> 9) & 1) << 5)); }
__device__ __forceinline__ void stage_rc(int b, int& R, int& C) { const int st = b / 1024, sb = b % 1024, swz = sb ^ (((sb >> 9) & 1) << 5); R = (st >> 1) * 16 + swz / 64; C = (st & 1) * 32 + (swz % 64) / 2; }
__device__ __forceinline__ bool unit_next(int i, int G, int c, int nM, int nN, int& pm, int& pn) {
  const int nwg = nM * nN;
  const long L = (long)i * G + c; if (L >= nwg) return false;
  int wgid = (int)L; { const int q = nwg / 8, r = nwg % 8, xcd = wgid % 8, off = wgid / 8; wgid = (xcd < r ? xcd * (q + 1) : r * (q + 1) + (xcd - r) * q) + off; }
  const int nig = 8 * nN, gid = wgid / nig, fm = gid * 8, gsz = (nM - fm) < 8 ? (nM - fm) : 8;
  pm = fm + ((wgid % nig) % gsz); pn = (wgid % nig) / gsz; return true;
}

template <int MODE>
__device__ __forceinline__ void gemm_epilogue(PRef p, const GArgs& g, const f32x4 (&acc)[2][2][4][2], int pm, int pn, int wr, int wc, int fr, int fq) {
#pragma unroll
  for (int ai = 0; ai < 2; ++ai)
#pragma unroll
    for (int m = 0; m < 4; ++m) {
      const int row = pm * 256 + ai * 128 + wr * 64 + m * 16 + fr;
#pragma unroll
      for (int bj = 0; bj < 2; ++bj) {
        const int cb = pn * 256 + bj * 128 + wc * 32 + 4 * fq;
        if constexpr (MODE == M_PART) {
#pragma unroll
          for (int n = 0; n < 2; ++n)
            *(f32x4*)(p.part + ((size_t)g.goff * 512 + row) * g.N + cb + n * 16) = acc[ai][bj][m][n];
        } else if constexpr (MODE == M_ADA) {
          if (row < NBR) {
#pragma unroll
            for (int n = 0; n < 2; ++n) {
              const int col = cb + n * 16;
              const f32x4 bias = col < 18432 ? *(const f32x4*)(p.in[I_ADAB] + col) : *(const f32x4*)(p.in[I_KVADAB] + (col - 18432));
              *(f32x4*)(p.mods + (size_t)row * MODW + col) = acc[ai][bj][m][n] + bias;
            }
          }
        } else if constexpr (MODE == M_SWIGLU) {
          if (bj == 0) {
            const int hc = pn * 128 + wc * 32 + 8 * fq;
            const f32x4 a0 = acc[ai][0][m][0], u0 = acc[ai][0][m][1], a1 = acc[ai][1][m][0], u1 = acc[ai][1][m][1];
            uint4 o;
            o.x = pack2(a0[0] * __builtin_amdgcn_rcpf(1.f + __expf(-a0[0])) * u0[0], a0[1] * __builtin_amdgcn_rcpf(1.f + __expf(-a0[1])) * u0[1]);
            o.y = pack2(a0[2] * __builtin_amdgcn_rcpf(1.f + __expf(-a0[2])) * u0[2], a0[3] * __builtin_amdgcn_rcpf(1.f + __expf(-a0[3])) * u0[3]);
            o.z = pack2(a1[0] * __builtin_amdgcn_rcpf(1.f + __expf(-a1[0])) * u1[0], a1[1] * __builtin_amdgcn_rcpf(1.f + __expf(-a1[1])) * u1[1]);
            o.w = pack2(a1[2] * __builtin_amdgcn_rcpf(1.f + __expf(-a1[2])) * u1[2], a1[3] * __builtin_amdgcn_rcpf(1.f + __expf(-a1[3])) * u1[3]);
            *(uint4*)(p.hid + (size_t)row * F + hc) = o;
          }
        } else if constexpr (MODE == M_RES) {
          const float* __restrict__ gm = p.mods + (size_t)brow_of(row) * MODW + g.goff;
          float* __restrict__ Xr = p.out;
          const float* xs = g.xsrc;
#pragma unroll
          for (int n = 0; n < 2; ++n) {
            const int col = cb + n * 16;
            f32x4* xp = (f32x4*)(Xr + (size_t)row * D + col);
            const f32x4 gv = *(const f32x4*)(gm + col);
            const f32x4 xin = (xs != (const float*)Xr) ? __builtin_nontemporal_load((const f32x4*)(xs + (size_t)row * D + col)) : *(const f32x4*)(xs + (size_t)row * D + col);
            *xp = g.alpha * xin + g.wgt * gv * acc[ai][bj][m][n];
          }
        } else if constexpr (MODE == M_MLIN) {
          const bool prompt = pm < 64;
          const int b = row >> 13, sq = row & 8191;
#pragma unroll
          for (int n = 0; n < 2; ++n) {
            const int col = cb + n * 16;
            f32x4 v = acc[ai][bj][m][n];
            if (pn < 2) {
              uint2 o; o.x = pack2(v[0], v[1]); o.y = pack2(v[2], v[3]);
              *(uint2*)(p.proj + (size_t)row * 2048 + col) = o;
            } else if (pn < 4) {
              v = v * 0.08838834764831845f;
              uint2 o; o.x = pack2(v[0], v[1]); o.y = pack2(v[2], v[3]);
              *(uint2*)(p.proj + (size_t)row * 2048 + col) = o;
              if (prompt) {
                const int c2 = col - 512, h = c2 >> 7, dk = c2 & 127;
                bf16* kp = p.kt + ((size_t)((b * 4 + h) * 128 + dk)) * SEQ + sq;
                kp[0] = f2bf(v[0]); kp[SEQ] = f2bf(v[1]); kp[2 * SEQ] = f2bf(v[2]); kp[3 * SEQ] = f2bf(v[3]);
              }
            } else if (pn < 8) {
              uint2 o; o.x = pack2(v[0], v[1]); o.y = pack2(v[2], v[3]);
              *(uint2*)(p.proj + (size_t)row * 2048 + (col - 1024) + 1024) = o;
            } else {
              const int c2 = col - 2048;
              if (prompt) {
                const int h = c2 >> 8, dv = c2 & 255;
                bf16* vp = p.vt + ((size_t)((b * 4 + h) * 256 + dv)) * SEQ + sq;
                vp[0] = f2bf(v[0]); vp[SEQ] = f2bf(v[1]); vp[2 * SEQ] = f2bf(v[2]); vp[3 * SEQ] = f2bf(v[3]);
              } else {
                uint2 o; o.x = pack2(v[0], v[1]); o.y = pack2(v[2], v[3]);
                *(uint2*)(p.vsamp + (size_t)(row - TP) * 1024 + c2) = o;
              }
            }
          }
        } else if constexpr (MODE == M_KV || MODE == M_Q) {
          const bool prompt = pm < 64;
#pragma unroll
          for (int n = 0; n < 2; ++n) {
            const int col = cb + n * 16;
            f32x4 v = acc[ai][bj][m][n];
            const bool rot = (MODE == M_Q || pn == 0) && n == 0 && (wc & 1) == 0;
            if (rot) {
              const int pos = pos_of(row);
#pragma unroll
              for (int j = 0; j < 4; ++j) {
                const float partner = __shfl_xor(v[j], 32);
                const float2 cs = p.rot[pos * 8 + ((4 * fq + j) & 7)];
                v[j] = (fq < 2) ? (v[j] * cs.x - partner * cs.y) : (v[j] * cs.x + partner * cs.y);
              }
            }
            if constexpr (MODE == M_Q) {
              v = v * 0.125f;
              uint2 o; o.x = pack2(v[0], v[1]); o.y = pack2(v[2], v[3]);
              *(uint2*)(p.q + (size_t)row * D + col) = o;
            } else {
              const bool isk = pn == 0;
              const int cc = col & 255, kvh = cc >> 6, d = cc & 63;
              if (isk) {
                uint2 o; o.x = pack2(v[0], v[1]); o.y = pack2(v[2], v[3]);
                *(uint2*)(p.ks + (size_t)row * 256 + cc) = o;
              } else if (prompt) {
                bf16* vp = p.vta + ((size_t)(((row >> 13) * 4 + kvh) * 64 + d)) * SEQ + (row & 8191);
                vp[0] = f2bf(v[0]); vp[SEQ] = f2bf(v[1]); vp[2 * SEQ] = f2bf(v[2]); vp[3 * SEQ] = f2bf(v[3]);
              }
              float* wout = p.out + (isk ? (prompt ? O_WKP : O_WKS) : (prompt ? O_WVP : O_WVS));
              if (prompt) {
                const int bb = row >> 13, sq = row & 8191;
                if (sq >= SEQ - 128) *(f32x4*)(wout + ((size_t)(bb * 128 + (sq - (SEQ - 128))) * 4 + kvh) * 64 + d) = v;
              } else {
                const int bb = (row - TP) >> 2, t = (row - TP) & 3;
                *(f32x4*)(wout + ((size_t)(bb * 128 + 124 + t) * 4 + kvh) * 64 + d) = v;
              }
            }
          }
        }
      }
    }
}

template <int MODE>
__device__ __forceinline__ void gemm_phase(PRef p, const GArgs& g, char* smem) {
  LAS unsigned char* lds = (LAS unsigned char*)smem;
  const int tid = opq_tid(), wid = __builtin_amdgcn_readfirstlane(tid >> 6), lane = tid & 63, wr = wid >> 2, wc = wid & 3, fr = lane & 15, fq = lane >> 4;
  const int K = g.K, nt = K / G_BK, lda = g.lda, ldb = g.ldb;
  const int nM = g.M / G_BM, nN = g.N / G_BM, G = g.uG ? g.uG : opq_gdim(), cid = g.uG ? g.ucid : opq_bid();
  unsigned voffA[2], voffB[2];
#pragma unroll
  for (int i = 0; i < 2; ++i) { int R, C; stage_rc(tid * 16 + i * 8192, R, C); voffA[i] = (unsigned)(R * lda + C) * 2u; voffB[i] = (unsigned)(R * ldb + C) * 2u; }
  const size_t kstep = (size_t)(G_BK * 2);
  const size_t hstepA = (size_t)G_HALF * lda * 2, hstepB = (size_t)G_HALF * ldb * 2;
  const size_t tstepA = 2 * hstepA, tstepB = 2 * hstepB;
  const unsigned ldsw = (unsigned)wid * 1024u;
  const int aoff = lds_byte(wr * 64 + fr, fq * 8), boff = lds_byte(wc * 32 + fr, fq * 8);
#define PG8_SA(b, h) (((b) * 2 + (h)) * G_HTB)
#define PG8_SB(b, h) ((4 + (b) * 2 + (h)) * G_HTB)
#define PG8_STAGE(bufoff, gbase, voff) do { _Pragma("unroll") for (int _i = 0; _i < 2; ++_i) \
        __builtin_amdgcn_global_load_lds((const unsigned*)((const char*)(gbase) + (voff)[_i]), (LAS unsigned*)(lds + (bufoff) + ldsw + _i * 8192), 16, 0, 0); } while (0)
#define PG8_LDA(dst, b, h) do { _Pragma("unroll") for (int m = 0; m < 4; ++m) _Pragma("unroll") for (int k = 0; k < 2; ++k) dst[m][k] = *(const LAS bf16x8*)(lds + PG8_SA(b, h) + aoff + m * 2048 + k * 1024); } while (0)
#define PG8_LDB(dst, b, h) do { _Pragma("unroll") for (int n = 0; n < 2; ++n) _Pragma("unroll") for (int k = 0; k < 2; ++k) dst[n][k] = *(const LAS bf16x8*)(lds + PG8_SB(b, h) + boff + n * 2048 + k * 1024); } while (0)
#define PG8_MMA(ai, bj, At, Bt) do { __builtin_amdgcn_s_setprio(1); _Pragma("unroll") for (int m = 0; m < 4; ++m) _Pragma("unroll") for (int n = 0; n < 2; ++n) _Pragma("unroll") for (int k = 0; k < 2; ++k) \
        acc[ai][bj][m][n] = __builtin_amdgcn_mfma_f32_16x16x32_bf16(Bt[n][k], At[m][k], acc[ai][bj][m][n], 0, 0, 0); __builtin_amdgcn_s_setprio(0); } while (0)
#define PG8_WAIT_V(n) asm volatile("s_waitcnt vmcnt(" #n ")" ::: "memory")
#define PG8_WAIT_L(n) asm volatile("s_waitcnt lgkmcnt(" #n ")" ::: "memory")
#define PG8_BAR __builtin_amdgcn_s_barrier()
#define PG8_SCHED __builtin_amdgcn_sched_barrier(0)
  int cpm, cpn, npm = 0, npn = 0, ui = 0;
  if (unit_next(0, G, cid, nM, nN, cpm, cpn)) {
    f32x4 acc[2][2][4][2];
#pragma unroll
    for (int a = 0; a < 2; ++a)
#pragma unroll
      for (int b = 0; b < 2; ++b)
#pragma unroll
        for (int m = 0; m < 4; ++m)
#pragma unroll
          for (int n = 0; n < 2; ++n) acc[a][b][m][n] = (f32x4){0.f, 0.f, 0.f, 0.f};
    bf16x8 At[4][2], B0[2][2], B1[2][2];
    const char* cA = (const char*)g.A + (size_t)cpm * tstepA; const char* cB = (const char*)g.Bt + (size_t)cpn * tstepB;
    PG8_STAGE(PG8_SB(0, 0), cB, voffB); PG8_STAGE(PG8_SB(0, 1), cB + hstepB, voffB); PG8_STAGE(PG8_SA(0, 0), cA, voffA); PG8_STAGE(PG8_SA(0, 1), cA + hstepA, voffA);
    if (wr == 1) PG8_BAR;
    PG8_WAIT_V(2); PG8_BAR;
    PG8_STAGE(PG8_SB(1, 0), cB + kstep, voffB); PG8_STAGE(PG8_SA(1, 0), cA + kstep, voffA); PG8_STAGE(PG8_SB(1, 1), cB + hstepB + kstep, voffB);
    PG8_WAIT_V(6); PG8_BAR;
    for (;;) {
      const bool has_next = unit_next(ui + 1, G, cid, nM, nN, npm, npn);
      const char* nA = has_next ? (const char*)g.A + (size_t)npm * tstepA : cA; const char* nB = has_next ? (const char*)g.Bt + (size_t)npn * tstepB : cB;
      for (int t = 0; t < nt; t += 2) {
        const bool last = (t == nt - 2);
        const char* a1 = cA + (size_t)(t + 1) * kstep;
        const char* a2 = last ? nA : cA + (size_t)(t + 2) * kstep; const char* b2 = last ? nB : cB + (size_t)(t + 2) * kstep;
        const char* a3 = a2 + kstep; const char* b3 = b2 + kstep;
        PG8_LDB(B0, 0, 0); PG8_LDB(B1, 0, 1); PG8_SCHED; PG8_LDA(At, 0, 0); PG8_STAGE(PG8_SA(1, 1), a1 + hstepA, voffA);
        PG8_WAIT_V(8); PG8_WAIT_L(0); PG8_BAR; PG8_MMA(0, 0, At, B0); PG8_MMA(0, 1, At, B1); PG8_BAR; PG8_SCHED;
        PG8_LDA(At, 0, 1); PG8_STAGE(PG8_SB(0, 0), b2, voffB); PG8_STAGE(PG8_SB(0, 1), b2 + hstepB, voffB); PG8_STAGE(PG8_SA(0, 0), a2, voffA);
        PG8_WAIT_V(8); PG8_WAIT_L(0); PG8_BAR; PG8_MMA(1, 0, At, B0); PG8_MMA(1, 1, At, B1); PG8_BAR; PG8_SCHED;
        PG8_LDB(B0, 1, 0); PG8_LDB(B1, 1, 1); PG8_SCHED; PG8_LDA(At, 1, 0); PG8_STAGE(PG8_SA(0, 1), a2 + hstepA, voffA);
        PG8_WAIT_V(8); PG8_WAIT_L(0); PG8_BAR; PG8_MMA(0, 0, At, B0); PG8_MMA(0, 1, At, B1); PG8_BAR; PG8_SCHED;
        PG8_LDA(At, 1, 1); PG8_STAGE(PG8_SB(1, 0), b3, voffB); PG8_STAGE(PG8_SB(1, 1), b3 + hstepB, voffB); PG8_STAGE(PG8_SA(1, 0), a3, voffA);
        PG8_WAIT_V(8); PG8_WAIT_L(0); PG8_BAR; PG8_MMA(1, 0, At, B0); PG8_MMA(1, 1, At, B1); PG8_BAR; PG8_SCHED;
      }
      if (wr == 0) PG8_BAR;
      gemm_epilogue<MODE>(p, g, acc, cpm, cpn, wr, wc, fr, fq);
      if (!has_next) break;
#pragma unroll
      for (int a = 0; a < 2; ++a)
#pragma unroll
        for (int b = 0; b < 2; ++b)
#pragma unroll
          for (int m = 0; m < 4; ++m)
#pragma unroll
            for (int n = 0; n < 2; ++n) acc[a][b][m][n] = (f32x4){0.f, 0.f, 0.f, 0.f};
      cpm = npm; cpn = npn; cA = nA; cB = nB; ++ui;
      if (wr == 1) PG8_BAR;
    }
    PG8_WAIT_V(0);
    PG8_BAR;
  }
#undef PG8_SA
#undef PG8_SB
#undef PG8_STAGE
#undef PG8_LDA
#undef PG8_LDB
#undef PG8_MMA
#undef PG8_WAIT_V
#undef PG8_WAIT_L
#undef PG8_BAR
#undef PG8_SCHED
}

struct LnArgs {
  int src_input;
  int layer, j;
  int hoff;
  int kvoff;
  int gates;
  int nsl;
  int pgoff; float pwgt;
  int xfirst;
  const bf16* w1; int n1; const bf16* w2; int n2;
};

__device__ __forceinline__ void ln_phase(PRef p, const LnArgs a, char* smem) {
  const int tid = opq_tid(), lane = tid & 63, wave = __builtin_amdgcn_readfirstlane(tid >> 6);
  float* wg = (float*)smem;
  if (a.gates) {
    for (int i = tid; i < 8192; i += NTHR) {
      int k = i >> 3, gi = i & 7;
      wg[gi * 1024 + k] = p.in[I_MLWIN][(size_t)k * 3080 + 3072 + gi];
    }
    __syncthreads();
  }
  u32x4 wv[9];
  {
    const int gtid = opq_bid() * NTHR + tid, gth = opq_gdim() * NTHR;
#pragma unroll
    for (int k = 0; k < 9; ++k) {
      const int idx = gtid + k * gth;
      wv[k] = (u32x4){0u, 0u, 0u, 0u};
      if (idx < a.n1) wv[k] = *(const u32x4*)(a.w1 + (size_t)idx * 8);
      else if (idx - a.n1 < a.n2) wv[k] = *(const u32x4*)(a.w2 + (size_t)(idx - a.n1) * 8);
    }
  }
  float* __restrict__ X = p.out;
  const float* __restrict__ lg = p.in[I_LNG] + (a.layer * 3 + a.j) * D;
  const float* __restrict__ lb = p.in[I_LNB] + (a.layer * 3 + a.j) * D;
  const float* __restrict__ modsr = p.mods;
  const float* __restrict__ partr = p.part;
  for (int row = opq_bid() * 8 + wave; row < T; row += opq_gdim() * 8) {
    float4 v[4];
    if (a.src_input == 2) {
#pragma unroll
      for (int i = 0; i < 4; ++i) v[i] = *(const float4*)(X + (size_t)row * D + i * 256 + lane * 4);
    } else if (a.src_input) {
      const float* src = row < TP ? p.in[I_XP] + (size_t)row * D : p.in[I_XS] + (size_t)(row - TP) * D;
#pragma unroll
      for (int i = 0; i < 4; ++i) v[i] = ldnt4(src + i * 256 + lane * 4);
    } else {
      if (a.xfirst && row >= TP) {
#pragma unroll
        for (int i = 0; i < 4; ++i) v[i] = *(const float4*)(p.in[I_XS] + (size_t)(row - TP) * D + i * 256 + lane * 4);
      } else {
#pragma unroll
        for (int i = 0; i < 4; ++i) v[i] = ldnt4(X + (size_t)row * D + i * 256 + lane * 4);
      }
      if (a.nsl > 0 && row >= TP) {
        const float* __restrict__ gmr = modsr + (size_t)brow_of(row) * MODW + a.pgoff;
#pragma unroll
        for (int i = 0; i < 4; ++i) {
          float4 ps = make_float4(0.f, 0.f, 0.f, 0.f);
          for (int sl = 0; sl < a.nsl; ++sl) {
            const float4 t4 = *(const float4*)(partr + ((size_t)sl * 512 + (row - TP)) * 1024 + i * 256 + lane * 4);
            ps.x += t4.x; ps.y += t4.y; ps.z += t4.z; ps.w += t4.w;
          }
          const float4 gg = *(const float4*)(gmr + i * 256 + lane * 4);
          v[i].x = ALPHA * v[i].x + a.pwgt * gg.x * ps.x; v[i].y = ALPHA * v[i].y + a.pwgt * gg.y * ps.y;
          v[i].z = ALPHA * v[i].z + a.pwgt * gg.z * ps.z; v[i].w = ALPHA * v[i].w + a.pwgt * gg.w * ps.w;
        }
      }
      float s = 0.f;
#pragma unroll
      for (int i = 0; i < 4; ++i) s += (v[i].x + v[i].y) + (v[i].z + v[i].w);
      const float mu = wave_sum(s) * (1.f / 1024.f);
      float qv = 0.f;
#pragma unroll
      for (int i = 0; i < 4; ++i) {
        v[i].x -= mu; v[i].y -= mu; v[i].z -= mu; v[i].w -= mu;
        qv += v[i].x * v[i].x + v[i].y * v[i].y + v[i].z * v[i].z + v[i].w * v[i].w;
      }
      const float rstd = rsqrtf(wave_sum(qv) * (1.f / 1024.f) + LN_EPS);
#pragma unroll
      for (int i = 0; i < 4; ++i) {
        const float4 gg = *(const float4*)(lg + i * 256 + lane * 4);
        const float4 bb = *(const float4*)(lb + i * 256 + lane * 4);
        v[i].x = v[i].x * rstd * gg.x + bb.x; v[i].y = v[i].y * rstd * gg.y + bb.y;
        v[i].z = v[i].z * rstd * gg.z + bb.z; v[i].w = v[i].w * rstd * gg.w + bb.w;
      }
    }
    if (a.src_input != 1) {
#pragma unroll
      for (int i = 0; i < 4; ++i) {
        if (a.hoff < 0 && a.kvoff < 0) __builtin_nontemporal_store((f32x4){v[i].x, v[i].y, v[i].z, v[i].w}, (f32x4*)(X + (size_t)row * D + i * 256 + lane * 4));
        else *(float4*)(X + (size_t)row * D + i * 256 + lane * 4) = v[i];
      }
    }
    const float* __restrict__ mrow = modsr + (size_t)brow_of(row) * MODW;
    if (a.kvoff >= 0) {
#pragma unroll
      for (int i = 0; i < 4; ++i) {
        const float4 sh = *(const float4*)(mrow + a.kvoff + i * 256 + lane * 4);
        const float4 sc = *(const float4*)(mrow + a.kvoff + 1024 + i * 256 + lane * 4);
        uint2 o;
        o.x = pack2(v[i].x * (1.f + sc.x) + sh.x, v[i].y * (1.f + sc.y) + sh.y);
        o.y = pack2(v[i].z * (1.f + sc.z) + sh.z, v[i].w * (1.f + sc.w) + sh.w);
        *(uint2*)(p.hkv + (size_t)row * D + i * 256 + lane * 4) = o;
      }
    }
    if (a.hoff >= 0) {
      float gacc[8];
#pragma unroll
      for (int gi = 0; gi < 8; ++gi) gacc[gi] = 0.f;
#pragma unroll
      for (int i = 0; i < 4; ++i) {
        const float4 sh = *(const float4*)(mrow + a.hoff + i * 256 + lane * 4);
        const float4 sc = *(const float4*)(mrow + a.hoff + 1024 + i * 256 + lane * 4);
        float4 h;
        h.x = v[i].x * (1.f + sc.x) + sh.x; h.y = v[i].y * (1.f + sc.y) + sh.y;
        h.z = v[i].z * (1.f + sc.z) + sh.z; h.w = v[i].w * (1.f + sc.w) + sh.w;
        uint2 o; o.x = pack2(h.x, h.y); o.y = pack2(h.z, h.w);
        *(uint2*)(p.H + (size_t)row * D + i * 256 + lane * 4) = o;
        if (a.gates) {
#pragma unroll
          for (int gi = 0; gi < 8; ++gi) {
            const float4 w4 = *(const float4*)(wg + gi * 1024 + i * 256 + lane * 4);
            gacc[gi] += h.x * w4.x + h.y * w4.y + h.z * w4.z + h.w * w4.w;
          }
        }
      }
      if (a.gates) {
#pragma unroll
        for (int gi = 0; gi < 8; ++gi) gacc[gi] = wave_sum(gacc[gi]);
        if (lane == 0) {
#pragma unroll
          for (int gi = 0; gi < 8; ++gi) {
            float x = gacc[gi] + p.in[I_MLBG][gi];
            if (gi >= 4) x = (x >= 0.f) ? -log1pf(expf(-x)) : (x - log1pf(expf(x)));
            p.gates[(size_t)row * 8 + gi] = x;
          }
        }
      }
    }
  }
  {
    unsigned x = 0u;
#pragma unroll
    for (int k = 0; k < 9; ++k) x ^= wv[k][0] ^ wv[k][1] ^ wv[k][2] ^ wv[k][3];
    if (x == 0x9e3779b9u && a.n1 < 0) p.dbg[1] = (int)x;
  }
}

__device__ __forceinline__ void mlstm_A_item(PRef p, int item, char* smem) {
  const int tid = vq_tid(), lane = tid & 63, wave = __builtin_amdgcn_readfirstlane(tid >> 6), l15 = lane & 15, q4 = lane >> 4;
  const int bh = item >> 7, c = item & 127, b = bh >> 2, h = bh & 3;
  const int tok0 = b * SEQ + c * 64;
  float* wsh = (float*)smem;
  const float lf = p.gates[(size_t)(tok0 + lane) * 8 + 4 + h], ip = p.gates[(size_t)(tok0 + lane) * 8 + h];
  const float bs = scan_add(lf, lane);
  const float Bt = __shfl(bs, 63);
  const float aa = Bt - bs + ip;
  const float ml = wave_max(aa);
  wsh[wave * 64 + lane] = expf(aa - ml);
  if (tid == 0) { p.ab[(bh * 128 + c) * 2] = Bt; p.ab[(bh * 128 + c) * 2 + 1] = ml; }
  __syncthreads();
  f32x4 acc[8][4];
  f32x4 accn[2];
#pragma unroll
  for (int i = 0; i < 8; ++i)
#pragma unroll
    for (int j = 0; j < 4; ++j) acc[i][j] = (f32x4){0.f, 0.f, 0.f, 0.f};
  accn[0] = accn[1] = (f32x4){0.f, 0.f, 0.f, 0.f};
  bf16x8 ones;
#pragma unroll
  for (int j = 0; j < 8; ++j) ones[j] = (l15 == 0) ? (short)0x3F80 : (short)0;
#pragma unroll
  for (int ks = 0; ks < 2; ++ks) {
    float wk[8];
#pragma unroll
    for (int j = 0; j < 8; ++j) wk[j] = wsh[wave * 64 + ks * 32 + q4 * 8 + j];
    bf16x8 bfr[4];
#pragma unroll
    for (int nb = 0; nb < 4; ++nb)
      bfr[nb] = *(const bf16x8*)(p.vt + ((size_t)(bh * 256 + wave * 64 + nb * 16 + l15)) * SEQ + c * 64 + ks * 32 + q4 * 8);
#pragma unroll
    for (int mb = 0; mb < 8; ++mb) {
      bf16x8 raw = *(const bf16x8*)(p.kt + ((size_t)(bh * 128 + mb * 16 + l15)) * SEQ + c * 64 + ks * 32 + q4 * 8);
      bf16x8 af;
#pragma unroll
      for (int j = 0; j < 8; ++j) af[j] = (short)f2bf(bf2f((bf16)raw[j]) * wk[j]);
#pragma unroll
      for (int nb = 0; nb < 4; ++nb) acc[mb][nb] = MFMA(af, bfr[nb], acc[mb][nb]);
      if ((mb >> 1) == wave) accn[mb & 1] = MFMA(af, ones, accn[mb & 1]);
    }
  }
#pragma unroll
  for (int mb = 0; mb < 8; ++mb)
#pragma unroll
    for (int nb = 0; nb < 4; ++nb) {
      const int dv = wave * 64 + nb * 16 + l15, dk0 = mb * 16 + q4 * 4;
      uint2 o; o.x = pack2(acc[mb][nb][0], acc[mb][nb][1]); o.y = pack2(acc[mb][nb][2], acc[mb][nb][3]);
      *(uint2*)(p.uck + ((size_t)((bh * 128 + c) * 256 + dv)) * 128 + dk0) = o;
    }
  if (l15 == 0) {
#pragma unroll
    for (int i = 0; i < 2; ++i)
#pragma unroll
      for (int jj = 0; jj < 4; ++jj)
        p.un[(size_t)(bh * 128 + c) * 128 + (wave * 2 + i) * 16 + q4 * 4 + jj] = accn[i][jj];
  }
  __syncthreads();
}

__device__ __forceinline__ void mlstm_sample_item(PRef p, int item, char* smem, bool dryrun) {
  const int tid = vq_tid(), lane = tid & 63, wave = __builtin_amdgcn_readfirstlane(tid >> 6);
  const int b = item >> 2, h = item & 3;
  const int tok0 = TP + b * 4;
  float* qs = (float*)smem;
  float* ksm = qs + 512;
  float* qk = ksm + 512;
  float* qn = qk + 16;
  float* red = qn + 4;
  float* qw = red + 32;
  for (int i = tid; i < 1024; i += 256) {
    const int t = (i >> 7) & 3, d = i & 127, isk = i >> 9;
    const float* pr = p.part + (size_t)(b * 4 + t) * 3072 + isk * 512 + h * 128 + d;
    float v = pr[0] + pr[(size_t)512 * 3072] + pr[(size_t)2 * 512 * 3072] + pr[(size_t)3 * 512 * 3072];
    if (isk) v *= 0.08838834764831845f;
    (isk ? ksm : qs)[t * 128 + d] = v;
  }
  float lf[4], ip[4], bt[4];
#pragma unroll
  for (int t = 0; t < 4; ++t) { ip[t] = p.gates[(size_t)(tok0 + t) * 8 + h]; lf[t] = p.gates[(size_t)(tok0 + t) * 8 + 4 + h]; }
  bt[0] = lf[0]; bt[1] = bt[0] + lf[1]; bt[2] = bt[1] + lf[2]; bt[3] = bt[2] + lf[3];
  const float m0 = p.in[I_STM][b * 4 + h];
  float gs[4], Mt[4], winit[4], emt[4];
  float G = -INFINITY;
#pragma unroll
  for (int t = 0; t < 4; ++t) {
    gs[t] = ip[t] - bt[t];
    G = fmaxf(G, gs[t]);
    Mt[t] = fmaxf(m0, G);
    winit[t] = expf(m0 - Mt[t]);
    emt[t] = expf(-(bt[t] + Mt[t]));
  }
  const float mnew = bt[3] + Mt[3];
  float wend[4];
#pragma unroll
  for (int s = 0; s < 4; ++s) wend[s] = expf(bt[3] - bt[s] + ip[s] - mnew);
  const float decay = expf(bt[3] + m0 - mnew);
  __syncthreads();
  {
    const int pr = tid >> 4, sub = tid & 15, t = pr >> 2, s = pr & 3;
    float a = 0.f;
#pragma unroll
    for (int j = 0; j < 8; ++j) a += qs[t * 128 + sub * 8 + j] * ksm[s * 128 + sub * 8 + j];
    a += __shfl_xor(a, 1); a += __shfl_xor(a, 2); a += __shfl_xor(a, 4); a += __shfl_xor(a, 8);
    if (sub == 0) qk[pr] = a;
    if (pr < 4) {
      float a2 = 0.f;
#pragma unroll
      for (int j = 0; j < 8; ++j) a2 += qs[pr * 128 + sub * 8 + j] * p.in[I_STN][(size_t)(b * 4 + h) * 128 + sub * 8 + j];
      a2 += __shfl_xor(a2, 1); a2 += __shfl_xor(a2, 2); a2 += __shfl_xor(a2, 4); a2 += __shfl_xor(a2, 8);
      if (sub == 0) qn[pr] = a2;
    }
  }
  for (int i = tid; i < 1024; i += 256) {
    const int dk = i >> 3, j = i & 7;
    qw[i] = (j < 4) ? qs[j * 128 + dk] : wend[j - 4] * ksm[(j - 4) * 128 + dk];
  }
  __syncthreads();
  float sw[4][4], den[4];
#pragma unroll
  for (int t = 0; t < 4; ++t) {
    float dsum = 0.f;
#pragma unroll
    for (int s = 0; s < 4; ++s) {
      sw[t][s] = (s <= t) ? qk[t * 4 + s] * expf(gs[s] - Mt[t]) : 0.f;
      dsum += sw[t][s];
    }
    den[t] = dsum + winit[t] * qn[t];
  }
  const int dv = tid;
  float vv[4];
#pragma unroll
  for (int s = 0; s < 4; ++s) {
    const float* pr = p.part + (size_t)(b * 4 + s) * 3072 + 2048 + h * 256 + dv;
    vv[s] = pr[0] + pr[(size_t)512 * 3072] + pr[(size_t)2 * 512 * 3072] + pr[(size_t)3 * 512 * 3072];
  }
  const float* __restrict__ C0 = p.in[I_STC] + (size_t)(b * 4 + h) * 128 * 256 + dv;
  float* __restrict__ C1 = p.out + O_CS + (size_t)(b * 4 + h) * 128 * 256 + dv;
  float qc[4] = {0.f, 0.f, 0.f, 0.f};
#pragma unroll 1
  for (int dk0 = 0; dk0 < 128; dk0 += 32) {
    float cb[32];
#pragma unroll
    for (int j = 0; j < 32; ++j) cb[j] = __builtin_nontemporal_load(C0 + (dk0 + j) * 256);
#pragma unroll
    for (int j = 0; j < 32; ++j) {
      const float c = cb[j];
      const float4 q4v = *(const float4*)(qw + (dk0 + j) * 8);
      const float4 k4v = *(const float4*)(qw + (dk0 + j) * 8 + 4);
      qc[0] += q4v.x * c; qc[1] += q4v.y * c; qc[2] += q4v.z * c; qc[3] += q4v.w * c;
      __builtin_nontemporal_store(decay * c + k4v.x * vv[0] + k4v.y * vv[1] + k4v.z * vv[2] + k4v.w * vv[3], C1 + (dk0 + j) * 256);
    }
  }
  float hh[4];
  float rs[8];
#pragma unroll
  for (int t = 0; t < 4; ++t) {
    float num = winit[t] * qc[t];
#pragma unroll
    for (int s = 0; s < 4; ++s) num += sw[t][s] * vv[s];
    hh[t] = num / fmaxf(fabsf(den[t]), emt[t]);
    rs[t] = hh[t]; rs[4 + t] = hh[t] * hh[t];
  }
#pragma unroll
  for (int i = 0; i < 8; ++i) rs[i] = wave_sum(rs[i]);
  if (lane == 0) {
#pragma unroll
    for (int i = 0; i < 8; ++i) red[wave * 8 + i] = rs[i];
  }
  __syncthreads();
  const float nw = p.in[I_MLNW][h * 256 + dv];
#pragma unroll
  for (int t = 0; t < 4; ++t) {
    const float s1 = red[t] + red[8 + t] + red[16 + t] + red[24 + t];
    const float s2 = red[4 + t] + red[12 + t] + red[20 + t] + red[28 + t];
    const float mu = s1 * (1.f / 256.f);
    const float var = fmaxf(s2 * (1.f / 256.f) - mu * mu, 0.f);
    const float* pro = p.part + (size_t)(b * 4 + t) * 3072 + 1024 + h * 256 + dv;
    const float o = pro[0] + pro[(size_t)512 * 3072] + pro[(size_t)2 * 512 * 3072] + pro[(size_t)3 * 512 * 3072];
    p.H[(size_t)(tok0 + t) * 1024 + h * 256 + dv] = f2bf((hh[t] - mu) * rsqrtf(var + LN_EPS) * nw * sigmoidf_(o));
  }
  if (tid < 128) {
    float nn = decay * p.in[I_STN][(size_t)(b * 4 + h) * 128 + tid];
#pragma unroll
    for (int s = 0; s < 4; ++s) nn += wend[s] * ksm[s * 128 + tid];
    p.out[O_NS + (size_t)(b * 4 + h) * 128 + tid] = nn;
  }
  if (tid == 0) p.out[O_MS + b * 4 + h] = mnew;
  __syncthreads();
}

__device__ __forceinline__ void mlstm_scan_phase(PRef p, char* smem, bool dryrun) {
  const int tid = vq_tid();
  float* fa = (float*)smem;
  float* fu = fa + 128;
  float* aB = fu + 128;
  float* aM = aB + 128;
  for (int w = vq_bid(); w < 256; w += vq_gdim()) {
    const int bh = w >> 5, sub = w & 31;
    if (tid < 128) { aB[tid] = p.ab[(bh * 128 + tid) * 2]; aM[tid] = p.ab[(bh * 128 + tid) * 2 + 1]; }
    __syncthreads();
    if (tid == 0) {
      float m = 0.f;
      for (int k = 0; k < 128; ++k) {
        const float Bk = aB[k], ml = aM[k];
        const float mn = fmaxf(Bk + m, ml);
        fa[k] = __expf(Bk + m - mn); fu[k] = __expf(ml - mn);
        aB[k] = m;
        m = mn;
      }
      aM[0] = m;
    }
    __syncthreads();
    if (sub == 0) {
      if (tid < 128) p.mk[bh * 129 + tid] = aB[tid];
      if (tid == 0) { p.mk[bh * 129 + 128] = aM[0]; p.out[O_MP + bh] = aM[0]; }
    }
    const int e4 = sub * 256 + tid;
    float c0 = 0.f, c1 = 0.f, c2 = 0.f, c3 = 0.f;
    bf16* base = p.uck + (size_t)bh * 128 * 32768 + (size_t)e4 * 4;
    for (int k0 = 0; k0 < 128; k0 += 16) {
      uint2 u[16];
#pragma unroll
      for (int j = 0; j < 16; ++j) u[j] = *(const uint2*)(base + (size_t)(k0 + j) * 32768);
#pragma unroll
      for (int j = 0; j < 16; ++j) {
        uint2 o; o.x = pack2(c0, c1); o.y = pack2(c2, c3);
        if (!dryrun) *(uint2*)(base + (size_t)(k0 + j) * 32768) = o;
        const float a = fa[k0 + j], f = fu[k0 + j];
        c0 = a * c0 + f * __uint_as_float(u[j].x << 16);
        c1 = a * c1 + f * __uint_as_float(u[j].x & 0xffff0000u);
        c2 = a * c2 + f * __uint_as_float(u[j].y << 16);
        c3 = a * c3 + f * __uint_as_float(u[j].y & 0xffff0000u);
      }
    }
    {
      const int e = e4 * 4, dv = e >> 7, dk = e & 127;
      float* o = p.out + O_CP + (size_t)bh * 32768;
      o[(dk + 0) * 256 + dv] = c0; o[(dk + 1) * 256 + dv] = c1; o[(dk + 2) * 256 + dv] = c2; o[(dk + 3) * 256 + dv] = c3;
    }
    if (sub == 1 && tid < 128) {
      float n = 0.f;
      for (int k0 = 0; k0 < 128; k0 += 16) {
        float un[16];
#pragma unroll
        for (int j = 0; j < 16; ++j) un[j] = p.un[(size_t)(bh * 128 + k0 + j) * 128 + tid];
#pragma unroll
        for (int j = 0; j < 16; ++j) {
          p.nk[(size_t)(bh * 128 + k0 + j) * 128 + tid] = n;
          n = fa[k0 + j] * n + fu[k0 + j] * un[j];
        }
      }
      p.out[O_NP + bh * 128 + tid] = n;
    }
    __syncthreads();
  }
}

__device__ __forceinline__ void mlstm_C_item(PRef p, int item, char* smem, bool dryrun) {
  const int tid = vq_tid(), lane = tid & 63, wave = __builtin_amdgcn_readfirstlane(tid >> 6), l15 = lane & 15, q4 = lane >> 4;
  const int bh = item >> 7, c = item & 127, b = bh >> 2, h = bh & 3;
  const int tok0 = b * SEQ + c * 64;
  bf16* Sb = (bf16*)smem;
  float* gsv = (float*)(smem + 9216);
  float* Mtv = gsv + 64;
  float* wiv = Mtv + 64;
  float* emv = wiv + 64;
  float* red = emv + 64;
  const float mk = p.mk[bh * 129 + c];
  if (wave == 0) {
    const float lf = p.gates[(size_t)(tok0 + lane) * 8 + 4 + h], ip = p.gates[(size_t)(tok0 + lane) * 8 + h];
    const float bt = scan_add(lf, lane);
    const float g = ip - bt;
    const float G = scan_max(g, lane);
    const float M = fmaxf(mk, G);
    gsv[lane] = g; Mtv[lane] = M; wiv[lane] = expf(mk - M); emv[lane] = expf(-(bt + M));
  }
  __syncthreads();
  {
    f32x4 sacc[4];
#pragma unroll
    for (int i = 0; i < 4; ++i) sacc[i] = (f32x4){0.f, 0.f, 0.f, 0.f};
#pragma unroll
    for (int ks = 0; ks < 4; ++ks) {
      const bf16x8 af = *(const bf16x8*)(p.proj + (size_t)(tok0 + wave * 16 + l15) * 2048 + h * 128 + ks * 32 + q4 * 8);
#pragma unroll
      for (int sb = 0; sb < 4; ++sb) {
        if (sb <= wave) {
          const bf16x8 bfr = *(const bf16x8*)(p.proj + (size_t)(tok0 + sb * 16 + l15) * 2048 + 512 + h * 128 + ks * 32 + q4 * 8);
          sacc[sb] = MFMA(af, bfr, sacc[sb]);
        }
      }
    }
#pragma unroll
    for (int sb = 0; sb < 4; ++sb) {
      const int s = sb * 16 + l15;
      const float g = gsv[s];
#pragma unroll
      for (int jj = 0; jj < 4; ++jj) {
        const int t = wave * 16 + q4 * 4 + jj;
        const float v = (s <= t) ? sacc[sb][jj] * __expf(g - Mtv[t]) : 0.f;
        Sb[t * 72 + s] = f2bf(v);
      }
    }
  }
  __syncthreads();
  f32x4 acc[4][4], accd[4];
#pragma unroll
  for (int i = 0; i < 4; ++i) {
    accd[i] = (f32x4){0.f, 0.f, 0.f, 0.f};
#pragma unroll
    for (int j = 0; j < 4; ++j) acc[i][j] = (f32x4){0.f, 0.f, 0.f, 0.f};
  }
  const bf16* __restrict__ ckb = p.uck + ((size_t)(bh * 128 + c) * 256) * 128;
  const float* __restrict__ nkp = p.nk + (size_t)(bh * 128 + c) * 128;
  const bf16* __restrict__ projr = p.proj;
  bf16x8 vfr[2][4];
#pragma unroll
  for (int ks = 0; ks < 2; ++ks)
#pragma unroll
    for (int nb = 0; nb < 4; ++nb) vfr[ks][nb] = *(const bf16x8*)(p.vt + ((size_t)(bh * 256 + wave * 64 + nb * 16 + l15)) * SEQ + c * 64 + ks * 32 + q4 * 8);
#pragma unroll 2
  for (int ks = 0; ks < 4; ++ks) {
    bf16x8 bfr[4], nfr;
#pragma unroll
    for (int nb = 0; nb < 4; ++nb) bfr[nb] = *(const bf16x8*)(ckb + (size_t)(wave * 64 + nb * 16 + l15) * 128 + ks * 32 + q4 * 8);
#pragma unroll
    for (int j = 0; j < 8; ++j) nfr[j] = (l15 == 0) ? (short)f2bf(nkp[ks * 32 + q4 * 8 + j]) : (short)0;
#pragma unroll
    for (int tb = 0; tb < 4; ++tb) {
      const bf16x8 af = *(const bf16x8*)(projr + (size_t)(tok0 + tb * 16 + l15) * 2048 + h * 128 + ks * 32 + q4 * 8);
#pragma unroll
      for (int nb = 0; nb < 4; ++nb) acc[tb][nb] = MFMA(af, bfr[nb], acc[tb][nb]);
      accd[tb] = MFMA(af, nfr, accd[tb]);
    }
  }
#pragma unroll
  for (int tb = 0; tb < 4; ++tb)
#pragma unroll
    for (int jj = 0; jj < 4; ++jj) {
      const float wi = wiv[tb * 16 + q4 * 4 + jj];
      accd[tb][jj] *= wi;
#pragma unroll
      for (int nb = 0; nb < 4; ++nb) acc[tb][nb][jj] *= wi;
    }
  bf16x8 ones;
#pragma unroll
  for (int j = 0; j < 8; ++j) ones[j] = (l15 == 0) ? (short)0x3F80 : (short)0;
#pragma unroll
  for (int ks = 0; ks < 2; ++ks) {
#pragma unroll
    for (int tb = 0; tb < 4; ++tb) {
      const bf16x8 af = *(const bf16x8*)(Sb + (tb * 16 + l15) * 72 + ks * 32 + q4 * 8);
#pragma unroll
      for (int nb = 0; nb < 4; ++nb) acc[tb][nb] = MFMA(af, vfr[ks][nb], acc[tb][nb]);
      accd[tb] = MFMA(af, ones, accd[tb]);
    }
  }
#pragma unroll
  for (int tb = 0; tb < 4; ++tb)
#pragma unroll
    for (int jj = 0; jj < 4; ++jj) {
      const int t = tb * 16 + q4 * 4 + jj;
      const float den = __shfl(accd[tb][jj], lane & 48);
      const float inv = 1.f / fmaxf(fabsf(den), emv[t]);
      float s1 = 0.f, s2 = 0.f;
#pragma unroll
      for (int nb = 0; nb < 4; ++nb) { const float hv = acc[tb][nb][jj] * inv; acc[tb][nb][jj] = hv; s1 += hv; s2 += hv * hv; }
      s1 += __shfl_xor(s1, 1); s1 += __shfl_xor(s1, 2); s1 += __shfl_xor(s1, 4); s1 += __shfl_xor(s1, 8);
      s2 += __shfl_xor(s2, 1); s2 += __shfl_xor(s2, 2); s2 += __shfl_xor(s2, 4); s2 += __shfl_xor(s2, 8);
      if (l15 == 0) { red[(wave * 64 + t) * 2] = s1; red[(wave * 64 + t) * 2 + 1] = s2; }
    }
  __syncthreads();
  float nwv[4];
#pragma unroll
  for (int nb = 0; nb < 4; ++nb) nwv[nb] = p.in[I_MLNW][h * 256 + wave * 64 + nb * 16 + l15];
  bf16* __restrict__ yb = p.H;
#pragma unroll
  for (int tb = 0; tb < 4; ++tb) {
#pragma unroll
    for (int jj = 0; jj < 4; ++jj) {
      const int t = tb * 16 + q4 * 4 + jj;
      const float s1 = red[t * 2] + red[(64 + t) * 2] + red[(128 + t) * 2] + red[(192 + t) * 2];
      const float s2 = red[t * 2 + 1] + red[(64 + t) * 2 + 1] + red[(128 + t) * 2 + 1] + red[(192 + t) * 2 + 1];
      const float mu = s1 * (1.f / 256.f);
      const float rstd = rsqrtf(fmaxf(s2 * (1.f / 256.f) - mu * mu, 0.f) + LN_EPS);
#pragma unroll
      for (int nb = 0; nb < 4; ++nb) {
        const int dv = wave * 64 + nb * 16 + l15;
        const float o = bf2f(projr[(size_t)(tok0 + t) * 2048 + 1024 + h * 256 + dv]);
        const float yv = (acc[tb][nb][jj] - mu) * rstd * nwv[nb] * sigmoidf_(o);
        if (!dryrun) yb[(size_t)(tok0 + t) * 1024 + h * 256 + dv] = f2bf(yv);
        else if (yv == 1.2345e30f) p.mods[0] = 1.f;
      }
    }
  }
  __syncthreads();
}

__device__ __forceinline__ void attn_prompt_item(PRef p, int item, char* smem) {
  const int tid = vq_tid(), lane = tid & 63, wave = __builtin_amdgcn_readfirstlane(tid >> 6), l15 = lane & 15, q4 = lane >> 4;
  const int b = item >> 8, kvh = (item >> 6) & 3, nb = item & 63;
  const int qh = kvh * 4 + wave;
  const float sink = p.in[I_SINKS][qh];
  bf16* Pb = (bf16*)smem + wave * 16 * 168;
  const bf16x8 zero8 = (bf16x8){0, 0, 0, 0, 0, 0, 0, 0};
  for (int qt = 0; qt < 8; ++qt) {
    const int q0 = nb * 128 + qt * 16;
    bf16x8 qf[2];
#pragma unroll
    for (int ks = 0; ks < 2; ++ks) qf[ks] = *(const bf16x8*)(p.q + (size_t)(b * SEQ + q0 + l15) * D + qh * 64 + ks * 32 + q4 * 8);
    bf16x8 vfa[5][4];
#pragma unroll
    for (int ks = 0; ks < 5; ++ks) {
      const int kidx = q0 - 128 + ks * 32 + q4 * 8;
      const bool ok = (kidx >= 0) && !(ks == 4 && q4 >= 2);
#pragma unroll
      for (int db = 0; db < 4; ++db) {
        vfa[ks][db] = zero8;
        if (ok) vfa[ks][db] = *(const bf16x8*)(p.vta + ((size_t)((b * 4 + kvh) * 64 + db * 16 + l15)) * SEQ + kidx);
      }
    }
    f32x4 s[9];
#pragma unroll
    for (int kb = 0; kb < 9; ++kb) {
      s[kb] = (f32x4){0.f, 0.f, 0.f, 0.f};
      const int key0 = q0 - 128 + kb * 16;
      if (key0 >= 0) {
#pragma unroll
        for (int ks = 0; ks < 2; ++ks) {
          const bf16x8 kf = *(const bf16x8*)(p.ks + (size_t)(b * SEQ + key0 + l15) * 256 + kvh * 64 + ks * 32 + q4 * 8);
          s[kb] = MFMA(qf[ks], kf, s[kb]);
        }
      }
    }
    float mx[4], sum[4];
#pragma unroll
    for (int jj = 0; jj < 4; ++jj) {
      const int r = q4 * 4 + jj;
      float m = -INFINITY;
#pragma unroll
      for (int kb = 0; kb < 9; ++kb) {
        const int key0 = q0 - 128 + kb * 16;
        bool valid = key0 >= 0;
        if (kb == 0) valid = valid && (l15 > r);
        if (kb == 8) valid = valid && (l15 <= r);
        const float v = valid ? s[kb][jj] : -INFINITY;
        s[kb][jj] = v;
        m = fmaxf(m, v);
      }
      m = fmaxf(m, __shfl_xor(m, 1)); m = fmaxf(m, __shfl_xor(m, 2)); m = fmaxf(m, __shfl_xor(m, 4)); m = fmaxf(m, __shfl_xor(m, 8));
      m = fmaxf(m, sink);
      float sm = 0.f;
#pragma unroll
      for (int kb = 0; kb < 9; ++kb) {
        const float e = __expf(s[kb][jj] - m);
        sm += e;
        Pb[r * 168 + kb * 16 + l15] = f2bf(e);
      }
      Pb[r * 168 + 144 + l15] = 0;
      sm += __shfl_xor(sm, 1); sm += __shfl_xor(sm, 2); sm += __shfl_xor(sm, 4); sm += __shfl_xor(sm, 8);
      mx[jj] = m; sum[jj] = sm + __expf(sink - m);
    }
    __syncthreads();
    f32x4 o[4];
#pragma unroll
    for (int db = 0; db < 4; ++db) o[db] = (f32x4){0.f, 0.f, 0.f, 0.f};
#pragma unroll
    for (int ks = 0; ks < 5; ++ks) {
      const bf16x8 pf = *(const bf16x8*)(Pb + l15 * 168 + ks * 32 + q4 * 8);
#pragma unroll
      for (int db = 0; db < 4; ++db) o[db] = MFMA(pf, vfa[ks][db], o[db]);
    }
#pragma unroll
    for (int db = 0; db < 4; ++db)
#pragma unroll
      for (int jj = 0; jj < 4; ++jj) {
        const int r = q4 * 4 + jj;
        p.att[(size_t)(b * SEQ + q0 + r) * D + qh * 64 + db * 16 + l15] = f2bf(o[db][jj] / sum[jj]);
      }
    __syncthreads();
  }
}

__device__ __forceinline__ void attn_sample_item(PRef p, int item, char* smem) {
  const int tid = vq_tid();
  const int b = item >> 2, kvh = item & 3;
  float* qs = (float*)smem;
  float* sc = qs + 1024;
  float* rinv = sc + 16 * 132;
  const float* ck = p.in[I_CK]; const float* cv = p.in[I_CV];
  float* wk = p.out + O_WKS; float* wv = p.out + O_WVS;
  for (int i = tid; i < 124 * 16; i += 256) {
    const int r = i >> 4, c4 = (i & 15) * 4;
    { const float4 t4 = *(const float4*)(ck + ((size_t)(b * 128 + r + 4) * 4 + kvh) * 64 + c4);
      __builtin_nontemporal_store((f32x4){t4.x, t4.y, t4.z, t4.w}, (f32x4*)(wk + ((size_t)(b * 128 + r) * 4 + kvh) * 64 + c4)); }
    { const float4 t4 = *(const float4*)(cv + ((size_t)(b * 128 + r + 4) * 4 + kvh) * 64 + c4);
      __builtin_nontemporal_store((f32x4){t4.x, t4.y, t4.z, t4.w}, (f32x4*)(wv + ((size_t)(b * 128 + r) * 4 + kvh) * 64 + c4)); }
  }
  for (int i = tid; i < 1024; i += 256) {
    const int r = i >> 6, d = i & 63, t = r >> 2, g = r & 3;
    const int col = (kvh * 4 + g) * 64 + d;
    const float* pr = p.part + (size_t)(b * 4 + t) * 1024;
    float v = pr[col] + pr[(size_t)512 * 1024 + col] + pr[(size_t)2 * 512 * 1024 + col] + pr[(size_t)3 * 512 * 1024 + col];
    if (d < 16) {
      const int pc = d < 8 ? col + 8 : col - 8;
      const float v2 = pr[pc] + pr[(size_t)512 * 1024 + pc] + pr[(size_t)2 * 512 * 1024 + pc] + pr[(size_t)3 * 512 * 1024 + pc];
      const float2 cs = p.rot[(8192 + t) * 8 + (d & 7)];
      v = d < 8 ? v * cs.x - v2 * cs.y : v * cs.x + v2 * cs.y;
    }
    qs[i] = v * 0.125f;
  }
  __syncthreads();
  const int r = tid >> 4, sub = tid & 15, t = r >> 2, g = r & 3;
  const float sink = p.in[I_SINKS][kvh * 4 + g];
  float lmax = -INFINITY;
  for (int i = 0; i < 9; ++i) {
    const int key = sub + 16 * i;
    if (key < 132) {
      const float* kp = key < 128 ? ck + ((size_t)(b * 128 + key) * 4 + kvh) * 64 : wk + ((size_t)(b * 128 + 124 + key - 128) * 4 + kvh) * 64;
      float a = 0.f;
#pragma unroll
      for (int d4 = 0; d4 < 16; ++d4) {
        const float4 kv = *(const float4*)(kp + d4 * 4);
        const float4 qv = *(const float4*)(qs + r * 64 + d4 * 4);
        a += kv.x * qv.x + kv.y * qv.y + kv.z * qv.z + kv.w * qv.w;
      }
      const bool valid = key < 128 ? (key > t) : ((key - 128) <= t);
      a = valid ? a : -INFINITY;
      sc[r * 132 + key] = a;
      lmax = fmaxf(lmax, a);
    }
  }
  lmax = fmaxf(lmax, __shfl_xor(lmax, 1)); lmax = fmaxf(lmax, __shfl_xor(lmax, 2)); lmax = fmaxf(lmax, __shfl_xor(lmax, 4)); lmax = fmaxf(lmax, __shfl_xor(lmax, 8));
  lmax = fmaxf(lmax, sink);
  float lsum = 0.f;
  for (int i = 0; i < 9; ++i) {
    const int key = sub + 16 * i;
    if (key < 132) {
      const float e = __expf(sc[r * 132 + key] - lmax);
      sc[r * 132 + key] = e;
      lsum += e;
    }
  }
  lsum += __shfl_xor(lsum, 1); lsum += __shfl_xor(lsum, 2); lsum += __shfl_xor(lsum, 4); lsum += __shfl_xor(lsum, 8);
  if (sub == 0) rinv[r] = 1.f / (lsum + __expf(sink - lmax));
  __syncthreads();
  float4 o = make_float4(0.f, 0.f, 0.f, 0.f);
  {
    const float* vb0 = cv + ((size_t)(b * 128) * 4 + kvh) * 64 + sub * 4;
#pragma unroll 16
    for (int key = 0; key < 128; ++key) {
      const float4 vv = *(const float4*)(vb0 + (size_t)key * 256);
      const float pw = sc[r * 132 + key];
      o.x += pw * vv.x; o.y += pw * vv.y; o.z += pw * vv.z; o.w += pw * vv.w;
    }
    const float* vb1 = wv + ((size_t)(b * 128 + 124) * 4 + kvh) * 64 + sub * 4;
#pragma unroll
    for (int key = 0; key < 4; ++key) {
      const float4 vv = *(const float4*)(vb1 + (size_t)key * 256);
      const float pw = sc[r * 132 + 128 + key];
      o.x += pw * vv.x; o.y += pw * vv.y; o.z += pw * vv.z; o.w += pw * vv.w;
    }
  }
  const float ri = rinv[r];
  uint2 ov; ov.x = pack2(o.x * ri, o.y * ri); ov.y = pack2(o.z * ri, o.w * ri);
  *(uint2*)(p.att + (size_t)(TP + b * 4 + t) * D + (kvh * 4 + g) * 64 + sub * 4) = ov;
  __syncthreads();
}


#ifdef SELFCHECK
__device__ __forceinline__ unsigned dhash(unsigned a, unsigned b) { unsigned h = a * 2654435761u + b * 40503u + 12345u; h ^= h >> 15; h *= 2246822519u; h ^= h >> 13; return h; }
__device__ __forceinline__ bool dbad(float got, float want, float tol, float flo) { return !(fabsf(got - want) <= tol * (fabsf(want) + flo)); }
__device__ __forceinline__ float ddot(const bf16* a, const float* w, int ldw, int K) { float s = 0.f; for (int k = 0; k < K; ++k) s += bf2f(a[k]) * w[(size_t)k * ldw]; return s; }
__device__ __forceinline__ void dfail(PRef p, int code) { atomicMin(p.dbg, code); }
__device__ __forceinline__ void stashX(PRef p, int salt) {
  const int tid = threadIdx.x; const unsigned h = dhash(tid, salt);
  const int tok = (tid & 1) ? TP + (h % 512) : (h % TP); const int col = (h >> 12) % 1024;
  p.stash[tid] = p.out[(size_t)tok * D + col];
}
__device__ void selfcheck(PRef p, int ph, char* dsm) {
  const int tid = threadIdx.x;
  const unsigned h = dhash(tid, ph);
  const int tok = (tid & 1) ? TP + (h % 512) : (h % TP);
  const int brow = brow_of(tok);
  const float* mrow = p.mods + (size_t)brow * MODW;
  const int layer = ph >= 15 ? 1 : 0; const int lo = layer * 9216;
  if (ph == 0) {
    WDesc w; int di = tid & 15;
    w.src = p.wd[0].src; w.dst = p.wd[0].dst; w.K = p.wd[0].K; w.N = p.wd[0].N; w.ld = p.wd[0].ld;
#pragma unroll
    for (int i = 1; i < 16; ++i) if (di == i) { w.src = p.wd[i].src; w.dst = p.wd[i].dst; w.K = p.wd[i].K; w.N = p.wd[i].N; w.ld = p.wd[i].ld; }
    const int n = h % w.N, k = (h >> 8) % w.K;
    if (w.dst[(size_t)n * w.K + k] != f2bf(w.src[(size_t)k * w.ld + n])) dfail(p, 1);
    const int pos = h % 8196, fi = tid & 7;
    const float ang = (float)((double)pos * p.inv_freq[fi]);
    const float2 cs = p.rot[pos * 8 + fi];
    if (fabsf(cs.x - cosf(ang)) > 2e-3f || fabsf(cs.y - sinf(ang)) > 2e-3f) dfail(p, 26);
  } else if (ph == 1) {
    const int br = tid % NBR, col = h % MODW;
    const float* c = br < 2 ? p.in[I_CP] + br * 1024 : p.in[I_CS] + (br - 2) * 1024;
    const float* W = col < 9216 ? p.in[I_ADAW] + col : col < 18432 ? p.in[I_ADAW] + (size_t)1024 * 9216 + (col - 9216) : p.in[I_KVADAW] + (col - 18432);
    const int ld = col < 18432 ? 9216 : 2048;
    float s = col < 18432 ? p.in[I_ADAB][col] : p.in[I_KVADAB][col - 18432];
    for (int k = 0; k < 1024; ++k) { float v = c[k]; v = v / (1.f + expf(-v)); s += v * W[(size_t)k * ld]; }
    if (dbad(p.mods[(size_t)br * MODW + col], s, 0.02f, 0.5f)) dfail(p, 2);
  } else if (ph == 2) {
    const int col = (h >> 12) % 1024;
    const float x = tok < TP ? p.in[I_XP][(size_t)tok * D + col] : p.in[I_XS][(size_t)(tok - TP) * D + col];
    if (p.out[(size_t)tok * D + col] != x) dfail(p, 3);
    if (dbad(bf2f(p.H[(size_t)tok * D + col]), x * (1.f + mrow[1024 + col]) + mrow[col], 0.01f, 0.02f)) dfail(p, 3);
  } else if (ph == 3 || ph == 12 || ph == 15 || ph == 22) {
    const int j = (h >> 12) % F;
    const float* W = (ph == 3 ? p.in[I_F1U] : ph == 12 ? p.in[I_F2U] : ph == 15 ? p.in[I_F1U] + (size_t)1024 * 5632 : p.in[I_F2U] + (size_t)1024 * 5632);
    const float a = ddot(p.H + (size_t)tok * D, W + j, 5632, 1024), u = ddot(p.H + (size_t)tok * D, W + F + j, 5632, 1024);
    if (dbad(bf2f(p.hid[(size_t)tok * F + j]), a / (1.f + expf(-a)) * u, 0.03f, 1.0f)) dfail(p, ph + 1);
    if (ph == 15) {
      const int col = (h >> 5) % 512;
      float v = ddot(p.hkv + (size_t)tok * D, p.in[I_KVW] + col, 512, 1024);
      const int cc = col & 255, kvh = cc >> 6, d = cc & 63;
      if (col < 256 && d < 16) {
        const int pcol = d < 8 ? col + 8 : col - 8;
        const float v2 = ddot(p.hkv + (size_t)tok * D, p.in[I_KVW] + pcol, 512, 1024);
        const float ang = (float)((double)pos_of(tok) * p.inv_freq[d & 7]);
        v = d < 8 ? v * cosf(ang) - v2 * sinf(ang) : v * cosf(ang) + v2 * sinf(ang);
      }
      float got;
      if (col < 256) got = bf2f(p.ks[(size_t)tok * 256 + cc]);
      else if (tok < TP) got = bf2f(p.vta[((size_t)((tok >> 13) * 4 + kvh) * 64 + d) * SEQ + (tok & 8191)]);
      else got = p.out[O_WVS + ((size_t)(((tok - TP) >> 2) * 128 + 124 + ((tok - TP) & 3)) * 4 + kvh) * 64 + d];
      if (dbad(got, v, 0.03f, 1.0f)) dfail(p, 27);
      if (tok >= TP) {
        const float g2 = p.out[(col < 256 ? O_WKS : O_WVS) + ((size_t)(((tok - TP) >> 2) * 128 + 124 + ((tok - TP) & 3)) * 4 + kvh) * 64 + d];
        if (dbad(g2, v, 0.03f, 1.0f)) dfail(p, 28);
      }
    }
    stashX(p, ph + 1);
  } else if (ph == 4 || ph == 13 || ph == 16 || ph == 23 || ph == 10 || ph == 20) {
    const unsigned h2 = dhash(tid, ph); const int tk = (tid & 1) ? TP + (h2 % 512) : (h2 % TP); const int col = (h2 >> 12) % 1024;
    const float* mr = p.mods + (size_t)brow_of(tk) * MODW;
    float acc, gate, wgt;
    if (ph == 10) { acc = ddot(p.proj + (size_t)tk * 2048 + 1024, p.in[I_MLWOUT] + col, 1024, 1024); gate = mr[lo + 5 * 1024 + col]; wgt = 1.f; }
    else if (ph == 20) { acc = ddot(p.att + (size_t)tk * D, p.in[I_ATTWO] + col, 1024, 1024); gate = mr[lo + 5 * 1024 + col]; wgt = 1.f; }
    else {
      const float* W = (ph == 4 ? p.in[I_F1D] : ph == 13 ? p.in[I_F2D] : ph == 16 ? p.in[I_F1D] + (size_t)F * 1024 : p.in[I_F2D] + (size_t)F * 1024);
      acc = ddot(p.hid + (size_t)tk * F, W + col, 1024, F); gate = mr[lo + ((ph == 4 || ph == 16) ? 2 : 8) * 1024 + col]; wgt = 0.5f;
    }
    const float want = ALPHA * p.stash[tid] + wgt * gate * acc;
    if (dbad(p.out[(size_t)tk * D + col], want, 0.02f, 1.0f)) dfail(p, ph + 1);
  } else if (ph == 5 || ph == 11 || ph == 14 || ph == 17 || ph == 21 || ph == 24) {
    const int j = (ph == 5 || ph == 17) ? 0 : (ph == 11 || ph == 21) ? 1 : 2;
    const float* lg = p.in[I_LNG] + (layer * 3 + j) * D; const float* lb = p.in[I_LNB] + (layer * 3 + j) * D;
    float s1 = 0.f, s2 = 0.f;
    for (int c = 0; c < 1024; ++c) { const float z = (p.out[(size_t)tok * D + c] - lb[c]) / lg[c]; s1 += z; s2 += z * z; }
    s1 *= (1.f / 1024.f); s2 = s2 * (1.f / 1024.f) - s1 * s1;
    if (fabsf(s1) > 0.01f || fabsf(s2 - 1.f) > 0.02f) dfail(p, ph + 1);
    const int hoff = ph == 5 ? 3072 : ph == 11 ? 6144 : ph == 14 ? 9216 : ph == 17 ? 9216 + 3072 : ph == 21 ? 9216 + 6144 : -1;
    const int col = (h >> 12) % 1024;
    const float x = p.out[(size_t)tok * D + col];
    if (hoff >= 0 && dbad(bf2f(p.H[(size_t)tok * D + col]), x * (1.f + mrow[hoff + 1024 + col]) + mrow[hoff + col], 0.01f, 0.02f)) dfail(p, 29);
    if (ph == 14 && dbad(bf2f(p.hkv[(size_t)tok * D + col]), x * (1.f + mrow[18432 + 1024 + col]) + mrow[18432 + col], 0.01f, 0.02f)) dfail(p, 30);
    if (ph == 5) {
      const int gi = tid & 7; float s = p.in[I_MLBG][gi];
      for (int c = 0; c < 1024; ++c) s += (p.out[(size_t)tok * D + c] * (1.f + mrow[3072 + 1024 + c]) + mrow[3072 + c]) * p.in[I_MLWIN][(size_t)c * 3080 + 3072 + gi];
      if (gi >= 4) s = -log1pf(expf(-s));
      if (dbad(p.gates[(size_t)tok * 8 + gi], s, 0.01f, 0.01f)) dfail(p, 31);
    }
    stashX(p, ph == 5 ? 10 : ph == 17 ? 20 : ph + 1);
  } else if (ph == 6) {
    const int col = (h >> 12) % 3072;
    float v = ddot(p.H + (size_t)tok * D, p.in[I_MLWIN] + col, 3080, 1024);
    if (col >= 512 && col < 1024) v *= 0.08838834764831845f;
    float got;
    if (col < 1024) got = bf2f(p.proj[(size_t)tok * 2048 + col]);
    else if (col >= 2048) got = bf2f(p.proj[(size_t)tok * 2048 + col - 1024]);
    else if (tok >= TP) got = bf2f(p.vsamp[(size_t)(tok - TP) * 1024 + col - 1024]);
    else { const int c2 = col - 1024; got = bf2f(p.vt[((size_t)((tok >> 13) * 4 + (c2 >> 8)) * 256 + (c2 & 255)) * SEQ + (tok & 8191)]); }
    if (dbad(got, v, 0.03f, 0.5f)) dfail(p, 7);
    if (col >= 512 && col < 1024 && tok < TP) {
      const int c2 = col - 512;
      if (dbad(bf2f(p.kt[((size_t)((tok >> 13) * 4 + (c2 >> 7)) * 128 + (c2 & 127)) * SEQ + (tok & 8191)]), v, 0.03f, 0.5f)) dfail(p, 32);
    }
  } else if (ph == 7) {
    {
      const int bh = h & 7, c = (h >> 3) & 127, dv = (h >> 10) & 255, dk = (h >> 18) & 127, b = bh >> 2, hh = bh & 3;
      const int tok0 = b * SEQ + c * 64;
      float B = 0.f;
      for (int s = 0; s < 64; ++s) B += p.gates[(size_t)(tok0 + s) * 8 + 4 + hh];
      float bs = 0.f, ml = -INFINITY;
      for (int s = 0; s < 64; ++s) { bs += p.gates[(size_t)(tok0 + s) * 8 + 4 + hh]; ml = fmaxf(ml, B - bs + p.gates[(size_t)(tok0 + s) * 8 + hh]); }
      bs = 0.f; float u = 0.f, un = 0.f;
      for (int s = 0; s < 64; ++s) {
        bs += p.gates[(size_t)(tok0 + s) * 8 + 4 + hh];
        const float w = expf(B - bs + p.gates[(size_t)(tok0 + s) * 8 + hh] - ml);
        const float k = bf2f(p.proj[(size_t)(tok0 + s) * 2048 + 512 + hh * 128 + dk]);
        u += w * k * bf2f(p.vt[((size_t)(bh * 256 + dv)) * SEQ + c * 64 + s]); un += w * k;
      }
      if (dbad(p.ab[(bh * 128 + c) * 2], B, 1e-3f, 1e-2f) || dbad(p.ab[(bh * 128 + c) * 2 + 1], ml, 1e-3f, 1e-2f)) dfail(p, 33);
      if (dbad(bf2f(p.uck[((size_t)((bh * 128 + c) * 256 + dv)) * 128 + dk]), u, 0.03f, 0.05f)) dfail(p, 8);
      if (dbad(p.un[(size_t)(bh * 128 + c) * 128 + dk], un, 0.03f, 0.1f)) dfail(p, 34);
    }
    {
      const int b = (h >> 4) & 127, hh = h & 3, dk = (h >> 11) & 127, dv = (h >> 18) & 255;
      const int tok0 = TP + b * 4;
      float lf[4], ip[4], bt[4];
#pragma unroll
      for (int t = 0; t < 4; ++t) { ip[t] = p.gates[(size_t)(tok0 + t) * 8 + hh]; lf[t] = p.gates[(size_t)(tok0 + t) * 8 + 4 + hh]; }
      bt[0] = lf[0]; bt[1] = bt[0] + lf[1]; bt[2] = bt[1] + lf[2]; bt[3] = bt[2] + lf[3];
      const float m0 = p.in[I_STM][b * 4 + hh];
      float mt3 = bt[3] + m0;
#pragma unroll
      for (int s = 0; s < 4; ++s) mt3 = fmaxf(mt3, bt[3] - bt[s] + ip[s]);
      float cn = expf(bt[3] + m0 - mt3) * p.in[I_STC][((size_t)(b * 4 + hh) * 128 + dk) * 256 + dv];
      float nn = expf(bt[3] + m0 - mt3) * p.in[I_STN][(size_t)(b * 4 + hh) * 128 + dk];
#pragma unroll
      for (int s = 0; s < 4; ++s) {
        const float we = expf(bt[3] - bt[s] + ip[s] - mt3);
        const float k = bf2f(p.proj[(size_t)(tok0 + s) * 2048 + 512 + hh * 128 + dk]);
        cn += we * k * bf2f(p.vsamp[(size_t)(b * 4 + s) * 1024 + hh * 256 + dv]); nn += we * k;
      }
      if (dbad(p.out[O_CS + ((size_t)(b * 4 + hh) * 128 + dk) * 256 + dv], cn, 0.02f, 0.01f)) dfail(p, 35);
      if (dbad(p.out[O_NS + (size_t)(b * 4 + hh) * 128 + dk], nn, 0.02f, 0.01f)) dfail(p, 36);
      if (dbad(p.out[O_MS + b * 4 + hh], mt3, 1e-3f, 1e-2f)) dfail(p, 37);
    }
  } else if (ph == 8) {
    const int bh = h & 7, k = (h >> 3) & 127, d = (h >> 10) & 127;
    float m = 0.f, n = 0.f;
    for (int j = 0; j < k; ++j) {
      const float Bj = p.ab[(bh * 128 + j) * 2], ml = p.ab[(bh * 128 + j) * 2 + 1];
      const float mn = fmaxf(Bj + m, ml);
      n = expf(Bj + m - mn) * n + expf(ml - mn) * p.un[(size_t)(bh * 128 + j) * 128 + d];
      m = mn;
    }
    if (dbad(p.nk[(size_t)(bh * 128 + k) * 128 + d], n, 0.01f, 0.01f)) dfail(p, 9);
    if (dbad(p.mk[bh * 129 + k], m, 1e-3f, 1e-2f)) dfail(p, 38);
    {
      const int c = 1 + (h >> 17) % 3, dv = (h >> 20) & 255, dk = d, b = bh >> 2, hh = bh & 3;
      float mm = 0.f, C = 0.f;
      for (int j = 0; j < c; ++j) {
        const int tok0 = b * SEQ + j * 64;
        float B = 0.f;
        for (int s = 0; s < 64; ++s) B += p.gates[(size_t)(tok0 + s) * 8 + 4 + hh];
        float bs = 0.f, ml = -INFINITY;
        for (int s = 0; s < 64; ++s) { bs += p.gates[(size_t)(tok0 + s) * 8 + 4 + hh]; ml = fmaxf(ml, B - bs + p.gates[(size_t)(tok0 + s) * 8 + hh]); }
        bs = 0.f; float u = 0.f;
        for (int s = 0; s < 64; ++s) {
          bs += p.gates[(size_t)(tok0 + s) * 8 + 4 + hh];
          u += expf(B - bs + p.gates[(size_t)(tok0 + s) * 8 + hh] - ml) * bf2f(p.proj[(size_t)(tok0 + s) * 2048 + 512 + hh * 128 + dk]) * bf2f(p.vt[((size_t)(bh * 256 + dv)) * SEQ + j * 64 + s]);
        }
        const float mn = fmaxf(B + mm, ml);
        C = expf(B + mm - mn) * C + expf(ml - mn) * u; mm = mn;
      }
      if (dbad(bf2f(p.uck[((size_t)((bh * 128 + c) * 256 + dv)) * 128 + dk]), C, 0.03f, 0.5f)) dfail(p, 39);
      if (bf2f(p.uck[((size_t)((bh * 128 + 0) * 256 + dv)) * 128 + dk]) != 0.f) dfail(p, 40);
    }
  } else if (ph == 9) {
    const int bh = h & 7, c = (h >> 3) & 127, t = (h >> 10) & 63, dvs = (h >> 16) & 255, b = bh >> 2, hh = bh & 3;
    const int tok0 = b * SEQ + c * 64, tk = tok0 + t;
    float* qk = (float*)dsm + tid * 64;
    const float mk = p.mk[bh * 129 + c];
    float bt = 0.f, G = -INFINITY;
    for (int s = 0; s <= t; ++s) {
      bt += p.gates[(size_t)(tok0 + s) * 8 + 4 + hh];
      const float g = p.gates[(size_t)(tok0 + s) * 8 + hh] - bt; G = fmaxf(G, g);
      float a = 0.f;
      for (int d = 0; d < 128; ++d) a += bf2f(p.proj[(size_t)tk * 2048 + hh * 128 + d]) * bf2f(p.proj[(size_t)(tok0 + s) * 2048 + 512 + hh * 128 + d]);
      qk[s] = a;
      qk[s] = a * 1.0f;
    }
    const float M = fmaxf(mk, G), wi = expf(mk - M), emt = expf(-(bt + M));
    { float b2 = 0.f; for (int s = 0; s <= t; ++s) { b2 += p.gates[(size_t)(tok0 + s) * 8 + 4 + hh]; qk[s] *= expf(p.gates[(size_t)(tok0 + s) * 8 + hh] - b2 - M); } }
    float den = 0.f;
    for (int s = 0; s <= t; ++s) den += qk[s];
    { float qn = 0.f; for (int d = 0; d < 128; ++d) qn += bf2f(p.proj[(size_t)tk * 2048 + hh * 128 + d]) * p.nk[(size_t)(bh * 128 + c) * 128 + d]; den += wi * qn; }
    const float inv = 1.f / fmaxf(fabsf(den), emt);
    float s1 = 0.f, s2 = 0.f, hs = 0.f;
    for (int dv = 0; dv < 256; ++dv) {
      float num = 0.f;
      for (int s = 0; s <= t; ++s) num += qk[s] * bf2f(p.vt[((size_t)(bh * 256 + dv)) * SEQ + c * 64 + s]);
      float qc = 0.f;
      for (int d = 0; d < 128; ++d) qc += bf2f(p.proj[(size_t)tk * 2048 + hh * 128 + d]) * bf2f(p.uck[((size_t)((bh * 128 + c) * 256 + dv)) * 128 + d]);
      const float hv = (num + wi * qc) * inv;
      s1 += hv; s2 += hv * hv; if (dv == dvs) hs = hv;
    }
    const float mu = s1 / 256.f, var = s2 / 256.f - mu * mu;
    const float o = ddot(p.H + (size_t)tk * D, p.in[I_MLWIN] + 2048 + hh * 256 + dvs, 3080, 1024);
    const float want = (hs - mu) * rsqrtf(var + LN_EPS) * p.in[I_MLNW][hh * 256 + dvs] / (1.f + expf(-o));
    if (dbad(bf2f(p.proj[(size_t)tk * 2048 + 1024 + hh * 256 + dvs]), want, 0.05f, 1.0f)) dfail(p, 10);
  } else if (ph == 18) {
    const int col = (h >> 12) % 1024, d = col & 63;
    float v = ddot(p.H + (size_t)tok * D, p.in[I_ATTWQ] + col, 1024, 1024);
    if (d < 16) {
      const int pcol = d < 8 ? col + 8 : col - 8;
      const float v2 = ddot(p.H + (size_t)tok * D, p.in[I_ATTWQ] + pcol, 1024, 1024);
      const float ang = (float)((double)pos_of(tok) * p.inv_freq[d & 7]);
      v = d < 8 ? v * cosf(ang) - v2 * sinf(ang) : v * cosf(ang) + v2 * sinf(ang);
    }
    if (dbad(bf2f(p.q[(size_t)tok * D + col]), v * 0.125f, 0.03f, 0.2f)) dfail(p, 19);
  } else if (ph == 19) {
    const int qh = (h >> 12) & 15, d = (h >> 16) & 63, kvh = qh >> 2;
    const float sink = p.in[I_SINKS][qh];
    const bf16* qp = p.q + (size_t)tok * D + qh * 64;
    float mx = sink, want;
    if (tok < TP) {
      const int b = tok >> 13, pos = tok & 8191;
      for (int pass = 0; pass < 2; ++pass) {
        float sum = 0.f, o = 0.f;
        for (int kp = pos - 127; kp <= pos; ++kp) {
          if (kp < 0) continue;
          float a = 0.f;
          for (int e = 0; e < 64; ++e) a += bf2f(qp[e]) * bf2f(p.ks[(size_t)(b * SEQ + kp) * 256 + kvh * 64 + e]);
          if (pass == 0) mx = fmaxf(mx, a);
          else { const float w = expf(a - mx); sum += w; o += w * bf2f(p.vta[((size_t)((b * 4 + kvh) * 64 + d)) * SEQ + kp]); }
        }
        want = o / (sum + expf(sink - mx));
      }
    } else {
      const int b = (tok - TP) >> 2, t = (tok - TP) & 3;
      for (int pass = 0; pass < 2; ++pass) {
        float sum = 0.f, o = 0.f;
        for (int key = 0; key < 132; ++key) {
          const bool valid = key < 128 ? (key > t) : ((key - 128) <= t);
          if (!valid) continue;
          const float* kp = key < 128 ? p.in[I_CK] + ((size_t)(b * 128 + key) * 4 + kvh) * 64 : p.out + O_WKS + ((size_t)(b * 128 + 124 + key - 128) * 4 + kvh) * 64;
          const float* vp = key < 128 ? p.in[I_CV] + ((size_t)(b * 128 + key) * 4 + kvh) * 64 : p.out + O_WVS + ((size_t)(b * 128 + 124 + key - 128) * 4 + kvh) * 64;
          float a = 0.f;
          for (int e = 0; e < 64; ++e) a += bf2f(qp[e]) * kp[e];
          if (pass == 0) mx = fmaxf(mx, a);
          else { const float w = expf(a - mx); sum += w; o += w * vp[d]; }
        }
        want = o / (sum + expf(sink - mx));
      }
    }
    if (dbad(bf2f(p.att[(size_t)tok * D + qh * 64 + d]), want, 0.03f, 0.3f)) dfail(p, 20);
  }
}
#endif

#define XB_TMO      128
#define XB_XCNT(j)  (256  + 64 * (j))
#define XB_XSUB(j)  (1280 + 64 * (j))
#define XB_XGEN(j)  (2304 + 64 * (j))
#define XB_TOP      3328
#define XB_TOPGEN   3392
#define XCD_BAR_WORDS 3456
#define XB_SPIN_CAP (1u << 18)
__device__ __forceinline__ unsigned xb_ld(unsigned* p)              { return __hip_atomic_load(p, __ATOMIC_RELAXED, __HIP_MEMORY_SCOPE_AGENT); }
__device__ __forceinline__ unsigned xb_add(unsigned* p, unsigned v) { return __hip_atomic_fetch_add(p, v, __ATOMIC_RELAXED, __HIP_MEMORY_SCOPE_AGENT); }
__device__ __forceinline__ unsigned xb_xcc_id() { return (unsigned)__builtin_amdgcn_s_getreg((3 << 11) | 20) & 0xFu; }
#define XB_SPIN(cond, bar) do { unsigned _sp = 0; while (cond) { __builtin_amdgcn_s_sleep(1); \
    if ((++_sp & 255u) == 0u) { if (xb_ld(&(bar)[XB_TMO])) break; if (_sp > XB_SPIN_CAP) { atomicAdd(&(bar)[XB_TMO], 1u); break; } } } } while (0)
struct XcdBarrier { unsigned* bar; unsigned x; volatile LAS unsigned* st; };
__device__ __forceinline__ XcdBarrier xcd_barrier_post(unsigned* bar, volatile LAS unsigned* st) {
  XcdBarrier b; b.bar = bar; b.x = xb_xcc_id(); b.st = st;
  if (threadIdx.x == 0) (void)xb_add(&bar[XB_XCNT(b.x)], 1u);
  return b;
}
__device__ __forceinline__ void xcd_barrier_complete(unsigned* bar, unsigned x, unsigned& nloc, unsigned& nx) {
  const unsigned G = gridDim.x * gridDim.y * gridDim.z;
  unsigned sum, cnt, mine, sp = 0u;
  for (;;) {
    sum = 0u; cnt = 0u; mine = 0u;
#pragma unroll
    for (unsigned j = 0; j < 16; ++j) { const unsigned c = xb_ld(&bar[XB_XCNT(j)]); sum += c; cnt += (c > 0u) ? 1u : 0u; mine = (j == x) ? c : mine; }
    if (sum == G) break;
    __builtin_amdgcn_s_sleep(1);
    if ((++sp & 255u) == 0u) { if (xb_ld(&bar[XB_TMO])) break; if (sp > XB_SPIN_CAP) { atomicAdd(&bar[XB_TMO], 1u); break; } }
  }
  nloc = mine > 0u ? mine : 1u; nx = cnt > 0u ? cnt : 1u;
}
__device__ __forceinline__ void xcd_barrier(const XcdBarrier& b) {
  asm volatile("s_waitcnt vmcnt(0)" ::: "memory");
  __syncthreads();
  if (threadIdx.x == 0) {
    unsigned* bar = b.bar;
    __builtin_amdgcn_s_waitcnt(0);
    unsigned nloc = b.st[0], nx = b.st[1];
    if (nloc == 0u) { xcd_barrier_complete(bar, b.x, nloc, nx); b.st[0] = nloc; b.st[1] = nx; }
    const unsigned old = xb_add(&bar[XB_XSUB(b.x)], 1u);
    const unsigned gen = old / nloc;
    if (old + 1u == (gen + 1u) * nloc) {
      __builtin_amdgcn_fence(__ATOMIC_RELEASE, "agent");
      asm volatile("s_waitcnt vmcnt(0)" ::: "memory");
      const unsigned og = xb_add(&bar[XB_TOP], 1u);
      const unsigned tg = og / nx;
      if (og + 1u == (tg + 1u) * nx) xb_add(&bar[XB_TOPGEN], 1u);
      else XB_SPIN(xb_ld(&bar[XB_TOPGEN]) == tg, bar);
      __builtin_amdgcn_fence(__ATOMIC_ACQUIRE, "agent");
      xb_add(&bar[XB_XGEN(b.x)], 1u);
      asm volatile("s_waitcnt vmcnt(0)" ::: "memory");
    } else {
      XB_SPIN(xb_ld(&bar[XB_XGEN(b.x)]) == gen, bar);
      __builtin_amdgcn_fence(__ATOMIC_ACQUIRE, "agent");
      asm volatile("s_waitcnt vmcnt(0)" ::: "memory");
    }
  }
  __syncthreads();
}

__global__ void __launch_bounds__(NTHR, 2) yoco_megakernel(Params p_unused) {
  cg::grid_group grid = cg::this_grid();
  __shared__ __attribute__((aligned(16))) char smem[LDS_BYTES];
  __shared__ uint4 xb_words;
  const __attribute__((address_space(4))) Params* pbase0 = (const __attribute__((address_space(4))) Params*)__builtin_amdgcn_kernarg_segment_ptr();
  unsigned* barw = pbase0->bar;
  if (threadIdx.x == 0) xb_words = make_uint4(0u, 0u, 0u, 0u);
  if (blockIdx.x == 0) for (int i = threadIdx.x; i < XCD_BAR_WORDS; i += NTHR) barw[i] = 0u;
  __syncthreads();
  XcdBarrier xb; xb.bar = barw; xb.x = 0u; xb.st = (volatile LAS unsigned*)&xb_words;
  bool posted = false;
  enum { K_PREP = 0, K_ADA, K_LN, K_UP, K_RES, K_MLIN, K_MLA, K_SCAN, K_MLC, K_Q, K_ATT };
  constexpr int NPH = 25;
  const __attribute__((address_space(4))) Params* pbase = (const __attribute__((address_space(4))) Params*)__builtin_amdgcn_kernarg_segment_ptr();
#pragma unroll 1
  for (int step = 0; step < NPH * PROBE_REP; ++step) {
    const int ph = step / PROBE_REP;
    const bool dry = (PROBE_REP == 2) && ((step & 1) == 0);
    if (dry && !((PROBE_MASK >> ph) & 1)) continue;
    const __attribute__((address_space(4))) Params* pp = pbase;
    asm volatile("" : "+s"(pp));
    PRef p = *pp;
    int kind = K_LN;
    int layer = ph >= 15 ? 1 : 0;
    const int lo = layer * 9216;
    int ffn = 0;
    int res_kind = 0;
    LnArgs la = LnArgs{0, layer, 0, -1, -1, 0, 0, 0, 0.f, 0, nullptr, 0, nullptr, 0};
    switch (ph) {
      case 0: kind = K_PREP; break;
      case 1: kind = K_ADA; break;
      case 2: la = LnArgs{1, 0, 0, 0, -1, 0, 0, 0, 0.f, 0, nullptr, 0, nullptr, 0}; break;
      case 3: case 15: kind = K_UP; ffn = 0; break;
      case 4: case 16: kind = K_RES; ffn = 0; break;
      case 5: la = LnArgs{0, 0, 0, 3 * 1024, -1, 1, 0, 0, 0.f, 0, nullptr, 0, nullptr, 0}; break;
      case 17: la = LnArgs{0, 1, 0, 9216 + 3 * 1024, -1, 0, 0, 0, 0.f, 0, nullptr, 0, nullptr, 0}; break;
      case 6: kind = K_MLIN; break;
      case 7: kind = K_MLA; break;
      case 8: kind = K_SCAN; break;
      case 9: kind = K_MLC; break;
      case 10: case 20: kind = K_RES; res_kind = 1; break;
      case 11: la = LnArgs{0, 0, 1, 6 * 1024, -1, 0, 0, 0, 0.f, 0, nullptr, 0, nullptr, 0}; break;
      case 21: la = LnArgs{0, 1, 1, 9216 + 6 * 1024, -1, 0, 0, 0, 0.f, 0, nullptr, 0, nullptr, 0}; break;
      case 12: case 22: kind = K_UP; ffn = 1; break;
      case 13: case 23: kind = K_RES; ffn = 1; break;
      case 14: la = LnArgs{0, 0, 2, 9216, 18432, 0, 0, 0, 0.f, 0, nullptr, 0, nullptr, 0}; break;
      case 18: kind = K_Q; break;
      case 19: kind = K_ATT; break;
      case 24: la = LnArgs{0, 1, 2, -1, -1, 0, 0, 0, 0.f, 0, nullptr, 0, nullptr, 0}; break;
      default: break;
    }
    {
      constexpr int NUP = 5632 * 1024 / 8, NDN = 1024 * 2816 / 8, NSQ = 1024 * 1024 / 8;
      if (ph == 2)  { la.w1 = p.wt_up[0]; la.n1 = NUP; la.w2 = p.wt_down[0]; la.n2 = NDN; }
      if (ph == 5)  { la.w1 = p.wt_mlin; la.n1 = 3 * NSQ; la.w2 = p.wt_mlout; la.n2 = NSQ; }
      if (ph == 11) { la.w1 = p.wt_up[1]; la.n1 = NUP; la.w2 = p.wt_down[1]; la.n2 = NDN; }
      if (ph == 14) { la.w1 = p.wt_up[2]; la.n1 = NUP; la.w2 = p.wt_down[2]; la.n2 = NDN; }
      if (ph == 17) { la.w1 = p.wt_q; la.n1 = NSQ; la.w2 = p.wt_o; la.n2 = NSQ; }
      if (ph == 21) { la.w1 = p.wt_up[3]; la.n1 = NUP; la.w2 = p.wt_down[3]; la.n2 = NDN; }
    }
    if (ph == 5) la.xfirst = 1;
    if (ph == 5 || ph == 17) { la.nsl = 11; la.pgoff = lo + 2 * 1024; la.pwgt = 0.5f; }
    if (ph == 14 || ph == 24) { la.nsl = 11; la.pgoff = lo + 8 * 1024; la.pwgt = 0.5f; }
    if (ph == 11 || ph == 21) { la.nsl = 4; la.pgoff = lo + 5 * 1024; la.pwgt = 1.0f; }
    switch (kind) {
      case K_PREP: phase_prep(p, smem); break;
      case K_ADA: {
        GArgs g = GArgs{p.cact, 1024, p.wt_ada, 1024, 256, MODW, 0, 0.f, ALPHA, 1024, 0, 0, p.out};
        gemm_phase<M_ADA>(p, g, smem);
      } break;
      case K_LN: if (dry) la.src_input = 2; ln_phase(p, la, smem); break;
      case K_UP: {
        const int wi = layer * 2 + ffn;
        const bf16* w = wi == 0 ? p.wt_up[0] : wi == 1 ? p.wt_up[1] : wi == 2 ? p.wt_up[2] : p.wt_up[3];
        GArgs g = GArgs{p.H, 1024, w, 1024, T, 2 * F, 0, 0.f, ALPHA, 1024, 0, 0, p.out};
        gemm_phase<M_SWIGLU>(p, g, smem);
        if (ph == 15) {
          GArgs g2 = GArgs{p.hkv, 1024, p.wt_kv, 1024, T, 512, 0, 0.f, ALPHA, 1024, opq_gdim(), opq_gdim() - 1 - opq_bid(), p.out};
          gemm_phase<M_KV>(p, g2, smem);
        }
      } break;
      case K_RES: {
        GArgs g;
        if (res_kind == 0) {
          const int wi = layer * 2 + ffn;
          const bf16* w = wi == 0 ? p.wt_down[0] : wi == 1 ? p.wt_down[1] : wi == 2 ? p.wt_down[2] : p.wt_down[3];
          g = GArgs{p.hid, F, w, F, T, 1024, lo + (ffn ? 8 : 2) * 1024, 0.5f, ALPHA, F, 0, 0, p.out};
        } else if (layer == 0) {
          g = GArgs{p.H, 1024, p.wt_mlout, 1024, T, 1024, lo + 5 * 1024, 1.0f, ALPHA, 1024, 0, 0, p.out};
        } else {
          g = GArgs{p.att, 1024, p.wt_o, 1024, T, 1024, lo + 5 * 1024, 1.0f, ALPHA, 1024, 0, 0, p.out};
        }
        if (ph == 4) g.xsrc = p.in[I_XP];
        if (dry) { g.alpha = 1.0f; g.wgt = 0.0f; g.xsrc = p.out; }
        g.M = TP;
        gemm_phase<M_RES>(p, g, smem);
        {
          const int nsl = g.K / 256, bid = opq_bid();
          if (bid < 8 * nsl) {
            const int sl = bid >> 3;
            GArgs g2 = GArgs{g.A + (size_t)TP * g.lda + sl * 256, g.lda, g.Bt + sl * 256, 256, 512, 1024, sl, 0.f, 0.f, g.K, 8, bid & 7, p.out};
            gemm_phase<M_PART>(p, g2, smem);
          }
        }
      } break;
      case K_MLIN: {
        GArgs g = GArgs{p.H, 1024, p.wt_mlin, 1024, TP, 3072, 0, 0.f, ALPHA, 1024, 0, 0, p.out};
        gemm_phase<M_MLIN>(p, g, smem);
        {
          const int bid = opq_bid();
          if (bid < 96) {
            const int sl = bid / 24;
            GArgs g2 = GArgs{p.H + (size_t)TP * 1024 + sl * 256, 1024, p.wt_mlin + sl * 256, 256, 512, 3072, sl, 0.f, 0.f, 1024, 24, bid % 24, p.out};
            gemm_phase<M_PART>(p, g2, smem);
          }
        }
      } break;
      case K_MLA:
        for (int it = vq_bid(); it < 1024; it += vq_gdim()) mlstm_A_item(p, it, smem + vq_vb() * VLDS);
        if (vq_gdim() != 512) for (int it = vq_bid(); it < 512; it += vq_gdim()) mlstm_sample_item(p, it, smem + vq_vb() * VLDS, dry);
        break;
      case K_SCAN:
        if (vq_gdim() == 512 && vq_bid() >= 256) { for (int it = vq_bid() - 256; it < 512; it += 256) mlstm_sample_item(p, it, smem + vq_vb() * VLDS, dry); }
        else mlstm_scan_phase(p, smem + vq_vb() * VLDS, dry);
        break;
      case K_MLC:
        for (int it = vq_bid(); it < 1024; it += vq_gdim()) mlstm_C_item(p, it, smem + vq_vb() * VLDS, dry);
        break;
      case K_Q: {
        GArgs g = GArgs{p.H, 1024, p.wt_q, 1024, TP, 1024, 0, 0.f, ALPHA, 1024, 0, 0, p.out};
        gemm_phase<M_Q>(p, g, smem);
        {
          const int bid = opq_bid();
          if (bid < 32) {
            const int sl = bid >> 3;
            GArgs g2 = GArgs{p.H + (size_t)TP * 1024 + sl * 256, 1024, p.wt_q + sl * 256, 256, 512, 1024, sl, 0.f, 0.f, 1024, 8, bid & 7, p.out};
            gemm_phase<M_PART>(p, g2, smem);
          }
        }
      } break;
      case K_ATT:
        for (int it = vq_bid(); it < 512; it += vq_gdim()) attn_prompt_item(p, it, smem + vq_vb() * VLDS);
        for (int it = vq_bid(); it < 512; it += vq_gdim()) attn_sample_item(p, it, smem + vq_vb() * VLDS);
        break;
      default: break;
    }
#ifdef SELFCHECK
    grid.sync();
    if (blockIdx.x == 0) {
      if (ph == 0 && threadIdx.x == 0) *p.dbg = 1000;
      __syncthreads();
      selfcheck(p, ph, smem);
    }
    grid.sync();
    if (ph + 1 == NPH && blockIdx.x == 0 && threadIdx.x == 0) {
      const int code = *p.dbg;
      if (code != 1000) p.out[0] = 1e4f * exp10f(0.4f * (float)code);
    }
#else
    if (step + 1 < NPH * PROBE_REP) {
      if (!posted) {
        grid.sync();
        xb = xcd_barrier_post(barw, (volatile LAS unsigned*)&xb_words);
        posted = true;
      } else { xcd_barrier(xb); if (PROBE_SYNC2) xcd_barrier(xb); }
    }
#endif
  }
}

extern "C" void kernel_launch(void* const* d_in, const int* in_sizes, int n_in, void* d_out, int out_size, void* d_ws, size_t ws_size, hipStream_t stream) {
  Params p;
  std::memset((void*)&p, 0, sizeof(p));
  for (int i = 0; i < 27; ++i) p.in[i] = (const float*)d_in[i];
  p.out = (float*)d_out;
  char* ws = (char*)d_ws;
  size_t off = 0;
  auto alloc = [&](size_t bytes) { char* r = ws + off; off += (bytes + 255) & ~(size_t)255; return r; };
  p.wt_ada = (bf16*)alloc((size_t)MODW * 1024 * 2);
  for (int i = 0; i < 4; ++i) p.wt_up[i] = (bf16*)alloc((size_t)5632 * 1024 * 2);
  for (int i = 0; i < 4; ++i) p.wt_down[i] = (bf16*)alloc((size_t)1024 * F * 2);
  p.wt_mlin = (bf16*)alloc((size_t)3072 * 1024 * 2);
  p.wt_mlout = (bf16*)alloc((size_t)1024 * 1024 * 2);
  p.wt_kv = (bf16*)alloc((size_t)512 * 1024 * 2);
  p.wt_q = (bf16*)alloc((size_t)1024 * 1024 * 2);
  p.wt_o = (bf16*)alloc((size_t)1024 * 1024 * 2);
  p.cact = (bf16*)alloc((size_t)256 * 1024 * 2);
  p.mods = (float*)alloc((size_t)NBR * MODW * 4);
  p.rot = (float2*)alloc((size_t)8196 * 8 * 8);
  p.H = (bf16*)alloc((size_t)T * 1024 * 2);
  p.gates = (float*)alloc((size_t)T * 8 * 4);
  char* arena = ws + off;
  size_t aoff = 0;
  auto aalloc = [&](size_t bytes) { char* r = arena + aoff; aoff += (bytes + 255) & ~(size_t)255; return r; };
  p.hid = (bf16*)arena;
  p.proj = (bf16*)aalloc((size_t)T * 2048 * 2);
  p.q = (bf16*)arena;
  p.att = (bf16*)(arena + (size_t)T * 1024 * 2);
  p.kt = (bf16*)aalloc((size_t)8 * 128 * SEQ * 2);
  p.vt = (bf16*)aalloc((size_t)8 * 256 * SEQ * 2);
  p.hkv = (bf16*)aalloc((size_t)T * 1024 * 2);
  p.ks = (bf16*)aalloc((size_t)T * 256 * 2);
  p.vta = (bf16*)aalloc((size_t)8 * 64 * SEQ * 2);
  size_t save = aoff;
  aoff = (size_t)((char*)p.hkv - arena);
  p.uck = (bf16*)aalloc((size_t)8 * 128 * 256 * 128 * 2);
  if (aoff < save) aoff = save;
  p.vsamp = (bf16*)aalloc((size_t)512 * 1024 * 2);
  p.un = (float*)aalloc((size_t)8 * 128 * 128 * 4);
  p.nk = (float*)aalloc((size_t)8 * 128 * 128 * 4);
  p.ab = (float*)aalloc((size_t)8 * 128 * 2 * 4);
  p.mk = (float*)aalloc((size_t)8 * 129 * 4);
  p.bar = (unsigned*)aalloc(XCD_BAR_WORDS * 4);
  p.part = (float*)aalloc((size_t)4 * 512 * 3072 * 4);
  p.dbg = (int*)aalloc(256);
  p.stash = (float*)aalloc(4096);
  int ts = 0, wi = 0;
  auto addw = [&](const float* src, bf16* dst, int K, int N, int ld, int mode) {
    p.wd[wi].src = src; p.wd[wi].dst = dst; p.wd[wi].K = K; p.wd[wi].N = N; p.wd[wi].ld = ld; p.wd[wi].tstart = ts; p.wd[wi].mode = mode;
    ts += (K / 64) * (N / 64); ++wi;
  };
  const float* const* in = (const float* const*)d_in;
  addw(in[I_ADAW], p.wt_ada, 1024, 9216, 9216, 0);
  addw(in[I_ADAW] + (size_t)1024 * 9216, p.wt_ada + (size_t)9216 * 1024, 1024, 9216, 9216, 0);
  addw(in[I_KVADAW], p.wt_ada + (size_t)18432 * 1024, 1024, 2048, 2048, 0);
  for (int l = 0; l < 2; ++l) {
    addw(in[I_F1U] + (size_t)l * 1024 * 5632, p.wt_up[l * 2 + 0], 1024, 5632, 5632, 1 | (l ? 2 : 0));
    addw(in[I_F2U] + (size_t)l * 1024 * 5632, p.wt_up[l * 2 + 1], 1024, 5632, 5632, 1 | (l ? 2 : 0));
    addw(in[I_F1D] + (size_t)l * F * 1024, p.wt_down[l * 2 + 0], F, 1024, 1024, (l ? 2 : 0));
    addw(in[I_F2D] + (size_t)l * F * 1024, p.wt_down[l * 2 + 1], F, 1024, 1024, (l ? 2 : 0));
  }
  addw(in[I_MLWIN], p.wt_mlin, 1024, 1024, 3080, 0);
  addw(in[I_MLWIN] + 2048, p.wt_mlin + (size_t)1024 * 1024, 1024, 1024, 3080, 0);
  addw(in[I_MLWIN] + 1024, p.wt_mlin + (size_t)2048 * 1024, 1024, 1024, 3080, 0);
  addw(in[I_MLWOUT], p.wt_mlout, 1024, 1024, 1024, 0);
  addw(in[I_KVW], p.wt_kv, 1024, 512, 512, 2);
  addw(in[I_ATTWQ], p.wt_q, 1024, 1024, 1024, 2);
  addw(in[I_ATTWO], p.wt_o, 1024, 1024, 1024, 2);
  p.wd_total = ts;
  for (; wi < 20; ++wi) p.wd[wi].tstart = 0x7fffffff;
  for (int i = 0; i < 8; ++i) p.inv_freq[i] = pow(500000.0, -(double)i / 8.0);

  static int grid_blocks = 0;
  if (!grid_blocks) {
    int dev = 0, cus = 0, per_cu = 0;
    (void)hipGetDevice(&dev);
    (void)hipDeviceGetAttribute(&cus, hipDeviceAttributeMultiprocessorCount, dev);
    (void)hipOccupancyMaxActiveBlocksPerMultiprocessor(&per_cu, yoco_megakernel, NTHR, 0);
    if (per_cu > 1) per_cu = 1;
    if (per_cu < 1) per_cu = 1;
    grid_blocks = cus * per_cu;
    grid_blocks &= ~7;
  }
  void* args[] = {&p};
  hipError_t e = hipLaunchCooperativeKernel((void*)yoco_megakernel, dim3(grid_blocks), dim3(NTHR), args, 0, stream);
  if (e != hipSuccess) fprintf(stderr, "cooperative launch failed: %s (grid %d)\n", hipGetErrorString(e), grid_blocks);
}
```

```cpp
#include <hip/hip_runtime.h>
#include <hip/hip_cooperative_groups.h>
#include <cstdio>
#include <cstdint>
#include <cmath>
#include <cstring>
namespace cg = cooperative_groups;

typedef unsigned short bf16;
typedef __attribute__((ext_vector_type(8))) short bf16x8;
typedef __attribute__((ext_vector_type(4))) float f32x4;
typedef __attribute__((ext_vector_type(4))) unsigned u32x4;

constexpr int D = 1024, T = 16896, TP = 16384, SEQ = 8192, F = 2816;
constexpr int NBR = 130;
constexpr int MODW = 20480;
constexpr float ALPHA = 1.4142135623730951f;
constexpr float LN_EPS = 1e-5f;
#ifndef PROBE_REP
#define PROBE_REP 1
#define PROBE_MASK 0
#endif
#ifndef PROBE_SYNC2
#define PROBE_SYNC2 0
#endif
constexpr int NTHR = 512;
constexpr int LDS_BYTES = 131072;
constexpr int VLDS = 32768;

constexpr size_t O_Y = 0;
constexpr size_t O_CP = 17301504;
constexpr size_t O_NP = 17563648;
constexpr size_t O_MP = 17564672;
constexpr size_t O_WKP = 17564680;
constexpr size_t O_WVP = 17630216;
constexpr size_t O_CS = 17695752;
constexpr size_t O_NS = 34472968;
constexpr size_t O_MS = 34538504;
constexpr size_t O_WKS = 34539016;
constexpr size_t O_WVS = 38733320;

struct Params;
struct WDesc { const float* src; bf16* dst; int K, N, ld, tstart, mode, pad; };

struct Params {
  const float* in[27];
  float* out;
  WDesc wd[20];
  int wd_total; int pad0;
  bf16 *wt_ada, *wt_up[4], *wt_down[4], *wt_mlin, *wt_mlout, *wt_kv, *wt_q, *wt_o;
  bf16* cact; float* mods; float2* rot; bf16* H; float* gates;
  bf16 *hid, *proj, *kt, *vt, *uck, *vsamp;
  float *un, *ab, *nk, *mk;
  bf16 *hkv, *ks, *vta, *q, *att;
  int* dbg; float* stash; unsigned* bar; float* part;
  double inv_freq[8];
};

typedef const __attribute__((address_space(4))) Params& PRef;

enum { I_XP = 0, I_XS, I_CP, I_CS, I_STC, I_STN, I_STM, I_CK, I_CV, I_ADAW, I_ADAB, I_F1U, I_F1D, I_F2U, I_F2D, I_LNG, I_LNB,
       I_MLWIN, I_MLBG, I_MLNW, I_MLWOUT, I_KVADAW, I_KVADAB, I_KVW, I_ATTWQ, I_SINKS, I_ATTWO };

__device__ __forceinline__ bf16 f2bf(float f) {
  unsigned u = __float_as_uint(f);
  u += 0x7fffu + ((u >> 16) & 1u);
  return (bf16)(u >> 16);
}
__device__ __forceinline__ float bf2f(bf16 h) { return __uint_as_float(((unsigned)h) << 16); }
__device__ __forceinline__ unsigned pack2(float a, float b) { return (unsigned)f2bf(a) | ((unsigned)f2bf(b) << 16); }
__device__ __forceinline__ int brow_of(int tok) { return tok < TP ? (tok >> 13) : 2 + ((tok - TP) >> 2); }
__device__ __forceinline__ int pos_of(int tok) { return tok < TP ? (tok & 8191) : 8192 + ((tok - TP) & 3); }
__device__ __forceinline__ float wave_sum(float v) {
#pragma unroll
  for (int o = 32; o > 0; o >>= 1) v += __shfl_xor(v, o);
  return v;
}
__device__ __forceinline__ float wave_max(float v) {
#pragma unroll
  for (int o = 32; o > 0; o >>= 1) v = fmaxf(v, __shfl_xor(v, o));
  return v;
}
__device__ __forceinline__ float scan_add(float x, int lane) {
#pragma unroll
  for (int o = 1; o < 64; o <<= 1) { float y = __shfl_up(x, o); if (lane >= o) x += y; }
  return x;
}
__device__ __forceinline__ float scan_max(float x, int lane) {
#pragma unroll
  for (int o = 1; o < 64; o <<= 1) { float y = __shfl_up(x, o); if (lane >= o) x = fmaxf(x, y); }
  return x;
}
__device__ __forceinline__ float sigmoidf_(float x) { return 1.f / (1.f + __expf(-x)); }
__device__ __forceinline__ int opq_tid() { int t = threadIdx.x; asm volatile("" : "+v"(t)); return t; }
__device__ __forceinline__ int opq_bid() { int t = blockIdx.x; asm volatile("" : "+s"(t)); return t; }
__device__ __forceinline__ int opq_gdim() { int t = gridDim.x; asm volatile("" : "+s"(t)); return t; }
__device__ __forceinline__ int vq_tid() { return opq_tid() & 255; }
__device__ __forceinline__ int vq_vb() { return __builtin_amdgcn_readfirstlane(opq_tid() >> 8); }
__device__ __forceinline__ int vq_bid() { return opq_bid() * 2 + vq_vb(); }
__device__ __forceinline__ int vq_gdim() { return opq_gdim() * 2; }
__device__ __forceinline__ float4 ldnt4(const float* q) { const f32x4 v = __builtin_nontemporal_load((const f32x4*)q); return make_float4(v[0], v[1], v[2], v[3]); }
#define MFMA(a, b, c) __builtin_amdgcn_mfma_f32_16x16x32_bf16(a, b, c, 0, 0, 0)

struct WInfo { const float* src; bf16* dst; int K, ld, mode, k0, n0; };
__device__ __forceinline__ WInfo prep_lookup(PRef p, int t) {
  WDesc w;
  w.src = p.wd[0].src; w.dst = p.wd[0].dst; w.K = p.wd[0].K; w.N = p.wd[0].N; w.ld = p.wd[0].ld; w.tstart = p.wd[0].tstart; w.mode = p.wd[0].mode;
#pragma unroll
  for (int i = 1; i < 20; ++i) if (t >= p.wd[i].tstart) { w.src = p.wd[i].src; w.dst = p.wd[i].dst; w.K = p.wd[i].K; w.N = p.wd[i].N; w.ld = p.wd[i].ld; w.tstart = p.wd[i].tstart; w.mode = p.wd[i].mode; }
  const int lt = t - w.tstart, nnt = w.N >> 6;
  WInfo r; r.src = w.src; r.dst = w.dst; r.K = w.K; r.ld = w.ld; r.mode = w.mode; r.n0 = (lt % nnt) * 64; r.k0 = (lt / nnt) * 64;
  return r;
}
__device__ __forceinline__ void phase_prep(PRef p, char* smem) {
  const int tid = vq_tid();
  float* tile = (float*)(smem + vq_vb() * VLDS);
  const int vbid = vq_bid(), vg = vq_gdim(), total = p.wd_total;
  const int kr = tid >> 4, nc = (tid & 15) * 4;
#define PREP_LOAD(R, W, ACT) do { if (ACT) { const float* sp = (W).src + (size_t)((W).k0 + kr) * (W).ld + (W).n0 + nc; \
    (R##0) = ldnt4(sp); (R##1) = ldnt4(sp + (size_t)16 * (W).ld); (R##2) = ldnt4(sp + (size_t)32 * (W).ld); (R##3) = ldnt4(sp + (size_t)48 * (W).ld); } } while (0)
#define PREP_TOLDS(R, ACT) do { if (ACT) { float* tp = tile + kr * 65 + nc; \
    tp[0] = (R##0).x; tp[1] = (R##0).y; tp[2] = (R##0).z; tp[3] = (R##0).w; \
    tp[16 * 65 + 0] = (R##1).x; tp[16 * 65 + 1] = (R##1).y; tp[16 * 65 + 2] = (R##1).z; tp[16 * 65 + 3] = (R##1).w; \
    tp[32 * 65 + 0] = (R##2).x; tp[32 * 65 + 1] = (R##2).y; tp[32 * 65 + 2] = (R##2).z; tp[32 * 65 + 3] = (R##2).w; \
    tp[48 * 65 + 0] = (R##3).x; tp[48 * 65 + 1] = (R##3).y; tp[48 * 65 + 2] = (R##3).z; tp[48 * 65 + 3] = (R##3).w; } } while (0)
#define PREP_STORE(W, ACT) do { if (ACT) { _Pragma("unroll") for (int i = 0; i < 2; ++i) { \
      int id = tid + i * 256; int n = id >> 3, kc = (id & 7) * 8; uint4 o; \
      o.x = pack2(tile[(kc + 0) * 65 + n], tile[(kc + 1) * 65 + n]); o.y = pack2(tile[(kc + 2) * 65 + n], tile[(kc + 3) * 65 + n]); \
      o.z = pack2(tile[(kc + 4) * 65 + n], tile[(kc + 5) * 65 + n]); o.w = pack2(tile[(kc + 6) * 65 + n], tile[(kc + 7) * 65 + n]); \
      int gn = (W).n0 + n; \
      if ((W).mode & 1) { const int isu = gn >= F; const int j = isu ? gn - F : gn; gn = (j >> 7) * 256 + ((j >> 2) & 1) * 128 + ((j >> 5) & 3) * 32 + isu * 16 + ((j >> 3) & 3) * 4 + (j & 3); } \
      if ((W).mode & 2) __builtin_nontemporal_store((u32x4){o.x, o.y, o.z, o.w}, (u32x4*)((W).dst + (size_t)gn * (W).K + (W).k0 + kc)); \
      else *(uint4*)((W).dst + (size_t)gn * (W).K + (W).k0 + kc) = o; } } } while (0)
  float4 ra0, ra1, ra2, ra3, rb0, rb1, rb2, rb3;
  ra0 = ra1 = ra2 = ra3 = rb0 = rb1 = rb2 = rb3 = make_float4(0.f, 0.f, 0.f, 0.f);
  int ta = vbid, tb = vbid + vg;
  bool acta = ta < total, actb = tb < total;
  WInfo wa = prep_lookup(p, acta ? ta : 0), wb = prep_lookup(p, actb ? tb : 0);
  PREP_LOAD(ra, wa, acta);
  PREP_LOAD(rb, wb, actb);
  for (int t0 = 0; t0 < total; t0 += 2 * vg) {
    PREP_TOLDS(ra, acta);
    __syncthreads();
    const WInfo wa_cur = wa; const bool acta_cur = acta;
    ta += 2 * vg; acta = ta < total; wa = prep_lookup(p, acta ? ta : 0);
    PREP_LOAD(ra, wa, acta);
    PREP_STORE(wa_cur, acta_cur);
    __syncthreads();
    PREP_TOLDS(rb, actb);
    __syncthreads();
    const WInfo wb_cur = wb; const bool actb_cur = actb;
    tb += 2 * vg; actb = tb < total; wb = prep_lookup(p, actb ? tb : 0);
    PREP_LOAD(rb, wb, actb);
    PREP_STORE(wb_cur, actb_cur);
    __syncthreads();
  }
#undef PREP_LOAD
#undef PREP_TOLDS
#undef PREP_STORE
  const int gt = opq_bid() * NTHR + opq_tid(), gs = opq_gdim() * NTHR;
  for (int i = gt; i < 256 * 1024; i += gs) {
    int r = i >> 10, c = i & 1023;
    float v = 0.f;
    if (r < 2) v = p.in[I_CP][r * 1024 + c]; else if (r < NBR) v = p.in[I_CS][(r - 2) * 1024 + c];
    v = v / (1.f + expf(-v));
    p.cact[i] = (r < NBR) ? f2bf(v) : (bf16)0;
  }
  for (int i = gt; i < 8196 * 8; i += gs) {
    int pos = i >> 3, fi = i & 7;
    double ang = (double)pos * p.inv_freq[fi];
    const double TWO_PI_HI = 6.283185307179586232, TWO_PI_LO = 2.449293598294706414e-16;
    double k = rint(ang * 0.15915494309189533577);
    double r = fma(-k, TWO_PI_HI, ang); r = fma(-k, TWO_PI_LO, r);
    double r2 = r * r;
    double s = 1.0, c = 1.0;
#pragma unroll 1
    for (int n = 14; n >= 1; --n) {
      s = 1.0 - s * r2 / (double)((2 * n) * (2 * n + 1));
      c = 1.0 - c * r2 / (double)((2 * n - 1) * (2 * n));
    }
    s *= r;
    p.rot[i] = make_float2((float)c, (float)s);
  }
}

enum { M_ADA = 0, M_SWIGLU, M_RES, M_MLIN, M_KV, M_Q, M_PART };
struct GArgs { const bf16* A; int lda; const bf16* Bt; int K; int M, N; int goff; float wgt; float alpha; int ldb, uG, ucid; const float* xsrc; };
#define LAS __attribute__((address_space(3)))
constexpr int G_BM = 256, G_BK = 64, G_HALF = 128, G_HTB = G_HALF * G_BK * 2;
__device__ __forceinline__ int lds_byte(int r, int c) { const int st = (r >> 4) * 2 + (c >> 5), rr = r & 15, cc = c & 31, ob = rr * 64 + cc * 2; return st * 1024 + (ob ^ (((ob >> 9) & 1) << 5)); }
__device__ __forceinline__ void stage_rc(int b, int& R, int& C) { const int st = b / 1024, sb = b % 1024, swz = sb ^ (((sb >> 9) & 1) << 5); R = (st >> 1) * 16 + swz / 64; C = (st & 1) * 32 + (swz % 64) / 2; }
__device__ __forceinline__ bool unit_next(int i, int G, int c, int nM, int nN, int& pm, int& pn) {
  const int nwg = nM * nN;
  const long L = (long)i * G + c; if (L >= nwg) return false;
  int wgid = (int)L; { const int q = nwg / 8, r = nwg % 8, xcd = wgid % 8, off = wgid / 8; wgid = (xcd < r ? xcd * (q + 1) : r * (q + 1) + (xcd - r) * q) + off; }
  constexpr int WGM = 4;
  const int nig = WGM * nN, gid = wgid / nig, fm = gid * WGM, gsz = (nM - fm) < WGM ? (nM - fm) : WGM;
  pm = fm + ((wgid % nig) % gsz); pn = (wgid % nig) / gsz; return true;
}

template <int MODE>
__device__ __forceinline__ void gemm_epilogue(PRef p, const GArgs& g, const f32x4 (&acc)[2][2][4][2], int pm, int pn, int wr, int wc, int fr, int fq) {
#pragma unroll
  for (int ai = 0; ai < 2; ++ai)
#pragma unroll
    for (int m = 0; m < 4; ++m) {
      const int row = pm * 256 + ai * 128 + wr * 64 + m * 16 + fr;
#pragma unroll
      for (int bj = 0; bj < 2; ++bj) {
        const int cb = pn * 256 + bj * 128 + wc * 32 + 4 * fq;
        if constexpr (MODE == M_PART) {
#pragma unroll
          for (int n = 0; n < 2; ++n)
            *(f32x4*)(p.part + ((size_t)g.goff * 512 + row) * g.N + cb + n * 16) = acc[ai][bj][m][n];
        } else if constexpr (MODE == M_ADA) {
          if (row < NBR) {
#pragma unroll
            for (int n = 0; n < 2; ++n) {
              const int col = cb + n * 16;
              const f32x4 bias = col < 18432 ? *(const f32x4*)(p.in[I_ADAB] + col) : *(const f32x4*)(p.in[I_KVADAB] + (col - 18432));
              *(f32x4*)(p.mods + (size_t)row * MODW + col) = acc[ai][bj][m][n] + bias;
            }
          }
        } else if constexpr (MODE == M_SWIGLU) {
          if (bj == 0) {
            const int hc = pn * 128 + wc * 32 + 8 * fq;
            const f32x4 a0 = acc[ai][0][m][0], u0 = acc[ai][0][m][1], a1 = acc[ai][1][m][0], u1 = acc[ai][1][m][1];
            uint4 o;
            o.x = pack2(a0[0] * __builtin_amdgcn_rcpf(1.f + __expf(-a0[0])) * u0[0], a0[1] * __builtin_amdgcn_rcpf(1.f + __expf(-a0[1])) * u0[1]);
            o.y = pack2(a0[2] * __builtin_amdgcn_rcpf(1.f + __expf(-a0[2])) * u0[2], a0[3] * __builtin_amdgcn_rcpf(1.f + __expf(-a0[3])) * u0[3]);
            o.z = pack2(a1[0] * __builtin_amdgcn_rcpf(1.f + __expf(-a1[0])) * u1[0], a1[1] * __builtin_amdgcn_rcpf(1.f + __expf(-a1[1])) * u1[1]);
            o.w = pack2(a1[2] * __builtin_amdgcn_rcpf(1.f + __expf(-a1[2])) * u1[2], a1[3] * __builtin_amdgcn_rcpf(1.f + __expf(-a1[3])) * u1[3]);
            *(uint4*)(p.hid + (size_t)row * F + hc) = o;
          }
        } else if constexpr (MODE == M_RES) {
          const float* __restrict__ gm = p.mods + (size_t)brow_of(row) * MODW + g.goff;
          float* __restrict__ Xr = p.out;
          const float* xs = g.xsrc;
#pragma unroll
          for (int n = 0; n < 2; ++n) {
            const int col = cb + n * 16;
            f32x4* xp = (f32x4*)(Xr + (size_t)row * D + col);
            const f32x4 gv = *(const f32x4*)(gm + col);
            const f32x4 xin = (xs != (const float*)Xr) ? __builtin_nontemporal_load((const f32x4*)(xs + (size_t)row * D + col)) : *(const f32x4*)(xs + (size_t)row * D + col);
            *xp = g.alpha * xin + g.wgt * gv * acc[ai][bj][m][n];
          }
        } else if constexpr (MODE == M_MLIN) {
          const bool prompt = pm < 64;
          const int b = row >> 13, sq = row & 8191;
#pragma unroll
          for (int n = 0; n < 2; ++n) {
            const int col = cb + n * 16;
            f32x4 v = acc[ai][bj][m][n];
            if (pn < 2) {
              uint2 o; o.x = pack2(v[0], v[1]); o.y = pack2(v[2], v[3]);
              *(uint2*)(p.proj + (size_t)row * 2048 + col) = o;
            } else if (pn < 4) {
              v = v * 0.08838834764831845f;
              uint2 o; o.x = pack2(v[0], v[1]); o.y = pack2(v[2], v[3]);
              *(uint2*)(p.proj + (size_t)row * 2048 + col) = o;
              if (prompt) {
                const int c2 = col - 512, h = c2 >> 7, dk = c2 & 127;
                bf16* kp = p.kt + ((size_t)((b * 4 + h) * 128 + dk)) * SEQ + sq;
                kp[0] = f2bf(v[0]); kp[SEQ] = f2bf(v[1]); kp[2 * SEQ] = f2bf(v[2]); kp[3 * SEQ] = f2bf(v[3]);
              }
            } else if (pn < 8) {
              uint2 o; o.x = pack2(v[0], v[1]); o.y = pack2(v[2], v[3]);
              *(uint2*)(p.proj + (size_t)row * 2048 + (col - 1024) + 1024) = o;
            } else {
              const int c2 = col - 2048;
              if (prompt) {
                const int h = c2 >> 8, dv = c2 & 255;
                bf16* vp = p.vt + ((size_t)((b * 4 + h) * 256 + dv)) * SEQ + sq;
                vp[0] = f2bf(v[0]); vp[SEQ] = f2bf(v[1]); vp[2 * SEQ] = f2bf(v[2]); vp[3 * SEQ] = f2bf(v[3]);
              } else {
                uint2 o; o.x = pack2(v[0], v[1]); o.y = pack2(v[2], v[3]);
                *(uint2*)(p.vsamp + (size_t)(row - TP) * 1024 + c2) = o;
              }
            }
          }
        } else if constexpr (MODE == M_KV || MODE == M_Q) {
          const bool prompt = pm < 64;
#pragma unroll
          for (int n = 0; n < 2; ++n) {
            const int col = cb + n * 16;
            f32x4 v = acc[ai][bj][m][n];
            const bool rot = (MODE == M_Q || pn == 0) && n == 0 && (wc & 1) == 0;
            if (rot) {
              const int pos = pos_of(row);
#pragma unroll
              for (int j = 0; j < 4; ++j) {
                const float partner = __shfl_xor(v[j], 32);
                const float2 cs = p.rot[pos * 8 + ((4 * fq + j) & 7)];
                v[j] = (fq < 2) ? (v[j] * cs.x - partner * cs.y) : (v[j] * cs.x + partner * cs.y);
              }
            }
            if constexpr (MODE == M_Q) {
              v = v * 0.125f;
              uint2 o; o.x = pack2(v[0], v[1]); o.y = pack2(v[2], v[3]);
              *(uint2*)(p.q + (size_t)row * D + col) = o;
            } else {
              const bool isk = pn == 0;
              const int cc = col & 255, kvh = cc >> 6, d = cc & 63;
              if (isk) {
                uint2 o; o.x = pack2(v[0], v[1]); o.y = pack2(v[2], v[3]);
                *(uint2*)(p.ks + (size_t)row * 256 + cc) = o;
              } else if (prompt) {
                bf16* vp = p.vta + ((size_t)(((row >> 13) * 4 + kvh) * 64 + d)) * SEQ + (row & 8191);
                vp[0] = f2bf(v[0]); vp[SEQ] = f2bf(v[1]); vp[2 * SEQ] = f2bf(v[2]); vp[3 * SEQ] = f2bf(v[3]);
              }
              float* wout = p.out + (isk ? (prompt ? O_WKP : O_WKS) : (prompt ? O_WVP : O_WVS));
              if (prompt) {
                const int bb = row >> 13, sq = row & 8191;
                if (sq >= SEQ - 128) *(f32x4*)(wout + ((size_t)(bb * 128 + (sq - (SEQ - 128))) * 4 + kvh) * 64 + d) = v;
              } else {
                const int bb = (row - TP) >> 2, t = (row - TP) & 3;
                *(f32x4*)(wout + ((size_t)(bb * 128 + 124 + t) * 4 + kvh) * 64 + d) = v;
              }
            }
          }
        }
      }
    }
}

template <int MODE>
__device__ __forceinline__ void gemm_phase(PRef p, const GArgs& g, char* smem) {
  LAS unsigned char* lds = (LAS unsigned char*)smem;
  const int tid = opq_tid(), wid = __builtin_amdgcn_readfirstlane(tid >> 6), lane = tid & 63, wr = wid >> 2, wc = wid & 3, fr = lane & 15, fq = lane >> 4;
  const int K = g.K, nt = K / G_BK, lda = g.lda, ldb = g.ldb;
  const int nM = g.M / G_BM, nN = g.N / G_BM, G = g.uG ? g.uG : opq_gdim(), cid = g.uG ? g.ucid : opq_bid();
  unsigned voffA[2], voffB[2];
#pragma unroll
  for (int i = 0; i < 2; ++i) { int R, C; stage_rc(tid * 16 + i * 8192, R, C); voffA[i] = (unsigned)(R * lda + C) * 2u; voffB[i] = (unsigned)(R * ldb + C) * 2u; }
  const size_t kstep = (size_t)(G_BK * 2);
  const size_t hstepA = (size_t)G_HALF * lda * 2, hstepB = (size_t)G_HALF * ldb * 2;
  const size_t tstepA = 2 * hstepA, tstepB = 2 * hstepB;
  const unsigned ldsw = (unsigned)wid * 1024u;
  const int aoff = lds_byte(wr * 64 + fr, fq * 8), boff = lds_byte(wc * 32 + fr, fq * 8);
#define PG8_SA(b, h) (((b) * 2 + (h)) * G_HTB)
#define PG8_SB(b, h) ((4 + (b) * 2 + (h)) * G_HTB)
#define PG8_STAGE(bufoff, gbase, voff) do { _Pragma("unroll") for (int _i = 0; _i < 2; ++_i) \
        __builtin_amdgcn_global_load_lds((const unsigned*)((const char*)(gbase) + (voff)[_i]), (LAS unsigned*)(lds + (bufoff) + ldsw + _i * 8192), 16, 0, 0); } while (0)
#define PG8_LDA(dst, b, h) do { _Pragma("unroll") for (int m = 0; m < 4; ++m) _Pragma("unroll") for (int k = 0; k < 2; ++k) dst[m][k] = *(const LAS bf16x8*)(lds + PG8_SA(b, h) + aoff + m * 2048 + k * 1024); } while (0)
#define PG8_LDB(dst, b, h) do { _Pragma("unroll") for (int n = 0; n < 2; ++n) _Pragma("unroll") for (int k = 0; k < 2; ++k) dst[n][k] = *(const LAS bf16x8*)(lds + PG8_SB(b, h) + boff + n * 2048 + k * 1024); } while (0)
#define PG8_MMA(ai, bj, At, Bt) do { __builtin_amdgcn_s_setprio(1); _Pragma("unroll") for (int m = 0; m < 4; ++m) _Pragma("unroll") for (int n = 0; n < 2; ++n) _Pragma("unroll") for (int k = 0; k < 2; ++k) \
        acc[ai][bj][m][n] = __builtin_amdgcn_mfma_f32_16x16x32_bf16(Bt[n][k], At[m][k], acc[ai][bj][m][n], 0, 0, 0); __builtin_amdgcn_s_setprio(0); } while (0)
#define PG8_WAIT_V(n) asm volatile("s_waitcnt vmcnt(" #n ")" ::: "memory")
#define PG8_WAIT_L(n) asm volatile("s_waitcnt lgkmcnt(" #n ")" ::: "memory")
#define PG8_BAR __builtin_amdgcn_s_barrier()
#define PG8_SCHED __builtin_amdgcn_sched_barrier(0)
  int cpm, cpn, npm = 0, npn = 0, ui = 0;
  if (unit_next(0, G, cid, nM, nN, cpm, cpn)) {
    f32x4 acc[2][2][4][2];
#pragma unroll
    for (int a = 0; a < 2; ++a)
#pragma unroll
      for (int b = 0; b < 2; ++b)
#pragma unroll
        for (int m = 0; m < 4; ++m)
#pragma unroll
          for (int n = 0; n < 2; ++n) acc[a][b][m][n] = (f32x4){0.f, 0.f, 0.f, 0.f};
    bf16x8 At[4][2], B0[2][2], B1[2][2];
    const char* cA = (const char*)g.A + (size_t)cpm * tstepA; const char* cB = (const char*)g.Bt + (size_t)cpn * tstepB;
    PG8_STAGE(PG8_SB(0, 0), cB, voffB); PG8_STAGE(PG8_SB(0, 1), cB + hstepB, voffB); PG8_STAGE(PG8_SA(0, 0), cA, voffA); PG8_STAGE(PG8_SA(0, 1), cA + hstepA, voffA);
    if (wr == 1) PG8_BAR;
    PG8_WAIT_V(2); PG8_BAR;
    PG8_STAGE(PG8_SB(1, 0), cB + kstep, voffB); PG8_STAGE(PG8_SA(1, 0), cA + kstep, voffA); PG8_STAGE(PG8_SB(1, 1), cB + hstepB + kstep, voffB);
    PG8_WAIT_V(6); PG8_BAR;
    for (;;) {
      const bool has_next = unit_next(ui + 1, G, cid, nM, nN, npm, npn);
      const char* nA = has_next ? (const char*)g.A + (size_t)npm * tstepA : cA; const char* nB = has_next ? (const char*)g.Bt + (size_t)npn * tstepB : cB;
      for (int t = 0; t < nt; t += 2) {
        const bool last = (t == nt - 2);
        const char* a1 = cA + (size_t)(t + 1) * kstep;
        const char* a2 = last ? nA : cA + (size_t)(t + 2) * kstep; const char* b2 = last ? nB : cB + (size_t)(t + 2) * kstep;
        const char* a3 = a2 + kstep; const char* b3 = b2 + kstep;
        PG8_LDB(B0, 0, 0); PG8_LDB(B1, 0, 1); PG8_SCHED; PG8_LDA(At, 0, 0); PG8_STAGE(PG8_SA(1, 1), a1 + hstepA, voffA);
        PG8_WAIT_V(8); PG8_WAIT_L(0); PG8_BAR; PG8_MMA(0, 0, At, B0); PG8_MMA(0, 1, At, B1); PG8_BAR; PG8_SCHED;
        PG8_LDA(At, 0, 1); PG8_STAGE(PG8_SB(0, 0), b2, voffB); PG8_STAGE(PG8_SB(0, 1), b2 + hstepB, voffB); PG8_STAGE(PG8_SA(0, 0), a2, voffA);
        PG8_WAIT_V(8); PG8_WAIT_L(0); PG8_BAR; PG8_MMA(1, 0, At, B0); PG8_MMA(1, 1, At, B1); PG8_BAR; PG8_SCHED;
        PG8_LDB(B0, 1, 0); PG8_LDB(B1, 1, 1); PG8_SCHED; PG8_LDA(At, 1, 0); PG8_STAGE(PG8_SA(0, 1), a2 + hstepA, voffA);
        PG8_WAIT_V(8); PG8_WAIT_L(0); PG8_BAR; PG8_MMA(0, 0, At, B0); PG8_MMA(0, 1, At, B1); PG8_BAR; PG8_SCHED;
        PG8_LDA(At, 1, 1); PG8_STAGE(PG8_SB(1, 0), b3, voffB); PG8_STAGE(PG8_SB(1, 1), b3 + hstepB, voffB); PG8_STAGE(PG8_SA(1, 0), a3, voffA);
        PG8_WAIT_V(8); PG8_WAIT_L(0); PG8_BAR; PG8_MMA(1, 0, At, B0); PG8_MMA(1, 1, At, B1); PG8_BAR; PG8_SCHED;
      }
      if (wr == 0) PG8_BAR;
      gemm_epilogue<MODE>(p, g, acc, cpm, cpn, wr, wc, fr, fq);
      if (!has_next) break;
#pragma unroll
      for (int a = 0; a < 2; ++a)
#pragma unroll
        for (int b = 0; b < 2; ++b)
#pragma unroll
          for (int m = 0; m < 4; ++m)
#pragma unroll
            for (int n = 0; n < 2; ++n) acc[a][b][m][n] = (f32x4){0.f, 0.f, 0.f, 0.f};
      cpm = npm; cpn = npn; cA = nA; cB = nB; ++ui;
      if (wr == 1) PG8_BAR;
    }
    PG8_WAIT_V(0);
    PG8_BAR;
  }
#undef PG8_SA
#undef PG8_SB
#undef PG8_STAGE
#undef PG8_LDA
#undef PG8_LDB
#undef PG8_MMA
#undef PG8_WAIT_V
#undef PG8_WAIT_L
#undef PG8_BAR
#undef PG8_SCHED
}

struct LnArgs {
  int src_input;
  int layer, j;
  int hoff;
  int kvoff;
  int gates;
  int nsl;
  int pgoff; float pwgt;
  int xfirst;
};

__device__ __forceinline__ void ln_phase(PRef p, const LnArgs a, char* smem) {
  const int tid = opq_tid(), lane = tid & 63, wave = __builtin_amdgcn_readfirstlane(tid >> 6);
  float* wg = (float*)smem;
  if (a.gates) {
    for (int i = tid; i < 8192; i += NTHR) {
      int k = i >> 3, gi = i & 7;
      wg[gi * 1024 + k] = p.in[I_MLWIN][(size_t)k * 3080 + 3072 + gi];
    }
    __syncthreads();
  }
  float* __restrict__ X = p.out;
  const float* __restrict__ lg = p.in[I_LNG] + (a.layer * 3 + a.j) * D;
  const float* __restrict__ lb = p.in[I_LNB] + (a.layer * 3 + a.j) * D;
  const float* __restrict__ modsr = p.mods;
  const float* __restrict__ partr = p.part;
  for (int row = opq_bid() * 8 + wave; row < T; row += opq_gdim() * 8) {
    float4 v[4];
    if (a.src_input == 2) {
#pragma unroll
      for (int i = 0; i < 4; ++i) v[i] = *(const float4*)(X + (size_t)row * D + i * 256 + lane * 4);
    } else if (a.src_input) {
      const float* src = row < TP ? p.in[I_XP] + (size_t)row * D : p.in[I_XS] + (size_t)(row - TP) * D;
#pragma unroll
      for (int i = 0; i < 4; ++i) v[i] = ldnt4(src + i * 256 + lane * 4);
    } else {
      if (a.xfirst && row >= TP) {
#pragma unroll
        for (int i = 0; i < 4; ++i) v[i] = *(const float4*)(p.in[I_XS] + (size_t)(row - TP) * D + i * 256 + lane * 4);
      } else {
#pragma unroll
        for (int i = 0; i < 4; ++i) v[i] = ldnt4(X + (size_t)row * D + i * 256 + lane * 4);
      }
      if (a.nsl > 0 && row >= TP) {
        const float* __restrict__ gmr = modsr + (size_t)brow_of(row) * MODW + a.pgoff;
#pragma unroll
        for (int i = 0; i < 4; ++i) {
          float4 ps = make_float4(0.f, 0.f, 0.f, 0.f);
          for (int sl = 0; sl < a.nsl; ++sl) {
            const float4 t4 = *(const float4*)(partr + ((size_t)sl * 512 + (row - TP)) * 1024 + i * 256 + lane * 4);
            ps.x += t4.x; ps.y += t4.y; ps.z += t4.z; ps.w += t4.w;
          }
          const float4 gg = *(const float4*)(gmr + i * 256 + lane * 4);
          v[i].x = ALPHA * v[i].x + a.pwgt * gg.x * ps.x; v[i].y = ALPHA * v[i].y + a.pwgt * gg.y * ps.y;
          v[i].z = ALPHA * v[i].z + a.pwgt * gg.z * ps.z; v[i].w = ALPHA * v[i].w + a.pwgt * gg.w * ps.w;
        }
      }
      float s = 0.f;
#pragma unroll
      for (int i = 0; i < 4; ++i) s += (v[i].x + v[i].y) + (v[i].z + v[i].w);
      const float mu = wave_sum(s) * (1.f / 1024.f);
      float qv = 0.f;
#pragma unroll
      for (int i = 0; i < 4; ++i) {
        v[i].x -= mu; v[i].y -= mu; v[i].z -= mu; v[i].w -= mu;
        qv += v[i].x * v[i].x + v[i].y * v[i].y + v[i].z * v[i].z + v[i].w * v[i].w;
      }
      const float rstd = rsqrtf(wave_sum(qv) * (1.f / 1024.f) + LN_EPS);
#pragma unroll
      for (int i = 0; i < 4; ++i) {
        const float4 gg = *(const float4*)(lg + i * 256 + lane * 4);
        const float4 bb = *(const float4*)(lb + i * 256 + lane * 4);
        v[i].x = v[i].x * rstd * gg.x + bb.x; v[i].y = v[i].y * rstd * gg.y + bb.y;
        v[i].z = v[i].z * rstd * gg.z + bb.z; v[i].w = v[i].w * rstd * gg.w + bb.w;
      }
    }
    if (a.src_input != 1) {
#pragma unroll
      for (int i = 0; i < 4; ++i) {
        if (a.hoff < 0 && a.kvoff < 0) __builtin_nontemporal_store((f32x4){v[i].x, v[i].y, v[i].z, v[i].w}, (f32x4*)(X + (size_t)row * D + i * 256 + lane * 4));
        else *(float4*)(X + (size_t)row * D + i * 256 + lane * 4) = v[i];
      }
    }
    const float* __restrict__ mrow = modsr + (size_t)brow_of(row) * MODW;
    if (a.kvoff >= 0) {
#pragma unroll
      for (int i = 0; i < 4; ++i) {
        const float4 sh = *(const float4*)(mrow + a.kvoff + i * 256 + lane * 4);
        const float4 sc = *(const float4*)(mrow + a.kvoff + 1024 + i * 256 + lane * 4);
        uint2 o;
        o.x = pack2(v[i].x * (1.f + sc.x) + sh.x, v[i].y * (1.f + sc.y) + sh.y);
        o.y = pack2(v[i].z * (1.f + sc.z) + sh.z, v[i].w * (1.f + sc.w) + sh.w);
        *(uint2*)(p.hkv + (size_t)row * D + i * 256 + lane * 4) = o;
      }
    }
    if (a.hoff >= 0) {
      float gacc[8];
#pragma unroll
      for (int gi = 0; gi < 8; ++gi) gacc[gi] = 0.f;
#pragma unroll
      for (int i = 0; i < 4; ++i) {
        const float4 sh = *(const float4*)(mrow + a.hoff + i * 256 + lane * 4);
        const float4 sc = *(const float4*)(mrow + a.hoff + 1024 + i * 256 + lane * 4);
        float4 h;
        h.x = v[i].x * (1.f + sc.x) + sh.x; h.y = v[i].y * (1.f + sc.y) + sh.y;
        h.z = v[i].z * (1.f + sc.z) + sh.z; h.w = v[i].w * (1.f + sc.w) + sh.w;
        uint2 o; o.x = pack2(h.x, h.y); o.y = pack2(h.z, h.w);
        *(uint2*)(p.H + (size_t)row * D + i * 256 + lane * 4) = o;
        if (a.gates) {
#pragma unroll
          for (int gi = 0; gi < 8; ++gi) {
            const float4 w4 = *(const float4*)(wg + gi * 1024 + i * 256 + lane * 4);
            gacc[gi] += h.x * w4.x + h.y * w4.y + h.z * w4.z + h.w * w4.w;
          }
        }
      }
      if (a.gates) {
#pragma unroll
        for (int gi = 0; gi < 8; ++gi) gacc[gi] = wave_sum(gacc[gi]);
        if (lane == 0) {
#pragma unroll
          for (int gi = 0; gi < 8; ++gi) {
            float x = gacc[gi] + p.in[I_MLBG][gi];
            if (gi >= 4) x = (x >= 0.f) ? -log1pf(expf(-x)) : (x - log1pf(expf(x)));
            p.gates[(size_t)row * 8 + gi] = x;
          }
        }
      }
    }
  }
}

__device__ __forceinline__ void mlstm_A_item(PRef p, int item, char* smem) {
  const int tid = vq_tid(), lane = tid & 63, wave = __builtin_amdgcn_readfirstlane(tid >> 6), l15 = lane & 15, q4 = lane >> 4;
  const int bh = item >> 7, c = item & 127, b = bh >> 2, h = bh & 3;
  const int tok0 = b * SEQ + c * 64;
  float* wsh = (float*)smem;
  const float lf = p.gates[(size_t)(tok0 + lane) * 8 + 4 + h], ip = p.gates[(size_t)(tok0 + lane) * 8 + h];
  const float bs = scan_add(lf, lane);
  const float Bt = __shfl(bs, 63);
  const float aa = Bt - bs + ip;
  const float ml = wave_max(aa);
  wsh[wave * 64 + lane] = expf(aa - ml);
  if (tid == 0) { p.ab[(bh * 128 + c) * 2] = Bt; p.ab[(bh * 128 + c) * 2 + 1] = ml; }
  __syncthreads();
  f32x4 acc[8][4];
  f32x4 accn[2];
#pragma unroll
  for (int i = 0; i < 8; ++i)
#pragma unroll
    for (int j = 0; j < 4; ++j) acc[i][j] = (f32x4){0.f, 0.f, 0.f, 0.f};
  accn[0] = accn[1] = (f32x4){0.f, 0.f, 0.f, 0.f};
  bf16x8 ones;
#pragma unroll
  for (int j = 0; j < 8; ++j) ones[j] = (l15 == 0) ? (short)0x3F80 : (short)0;
#pragma unroll
  for (int ks = 0; ks < 2; ++ks) {
    float wk[8];
#pragma unroll
    for (int j = 0; j < 8; ++j) wk[j] = wsh[wave * 64 + ks * 32 + q4 * 8 + j];
    bf16x8 bfr[4];
#pragma unroll
    for (int nb = 0; nb < 4; ++nb)
      bfr[nb] = *(const bf16x8*)(p.vt + ((size_t)(bh * 256 + wave * 64 + nb * 16 + l15)) * SEQ + c * 64 + ks * 32 + q4 * 8);
#pragma unroll
    for (int mb = 0; mb < 8; ++mb) {
      bf16x8 raw = *(const bf16x8*)(p.kt + ((size_t)(bh * 128 + mb * 16 + l15)) * SEQ + c * 64 + ks * 32 + q4 * 8);
      bf16x8 af;
#pragma unroll
      for (int j = 0; j < 8; ++j) af[j] = (short)f2bf(bf2f((bf16)raw[j]) * wk[j]);
#pragma unroll
      for (int nb = 0; nb < 4; ++nb) acc[mb][nb] = MFMA(af, bfr[nb], acc[mb][nb]);
      if ((mb >> 1) == wave) accn[mb & 1] = MFMA(af, ones, accn[mb & 1]);
    }
  }
#pragma unroll
  for (int mb = 0; mb < 8; ++mb)
#pragma unroll
    for (int nb = 0; nb < 4; ++nb) {
      const int dv = wave * 64 + nb * 16 + l15, dk0 = mb * 16 + q4 * 4;
      uint2 o; o.x = pack2(acc[mb][nb][0], acc[mb][nb][1]); o.y = pack2(acc[mb][nb][2], acc[mb][nb][3]);
      *(uint2*)(p.uck + ((size_t)((bh * 128 + c) * 256 + dv)) * 128 + dk0) = o;
    }
  if (l15 == 0) {
#pragma unroll
    for (int i = 0; i < 2; ++i)
#pragma unroll
      for (int jj = 0; jj < 4; ++jj)
        p.un[(size_t)(bh * 128 + c) * 128 + (wave * 2 + i) * 16 + q4 * 4 + jj] = accn[i][jj];
  }
  __syncthreads();
}

__device__ __forceinline__ void mlstm_sample_item(PRef p, int item, char* smem, bool dryrun) {
  const int tid = vq_tid(), lane = tid & 63, wave = __builtin_amdgcn_readfirstlane(tid >> 6);
  const int b = item >> 2, h = item & 3;
  const int tok0 = TP + b * 4;
  float* qs = (float*)smem;
  float* ksm = qs + 512;
  float* qk = ksm + 512;
  float* qn = qk + 16;
  float* red = qn + 4;
  float* qw = red + 32;
  for (int i = tid; i < 1024; i += 256) {
    const int t = (i >> 7) & 3, d = i & 127, isk = i >> 9;
    const float* pr = p.part + (size_t)(b * 4 + t) * 3072 + isk * 512 + h * 128 + d;
    float v = pr[0] + pr[(size_t)512 * 3072] + pr[(size_t)2 * 512 * 3072] + pr[(size_t)3 * 512 * 3072];
    if (isk) v *= 0.08838834764831845f;
    (isk ? ksm : qs)[t * 128 + d] = v;
  }
  float lf[4], ip[4], bt[4];
#pragma unroll
  for (int t = 0; t < 4; ++t) { ip[t] = p.gates[(size_t)(tok0 + t) * 8 + h]; lf[t] = p.gates[(size_t)(tok0 + t) * 8 + 4 + h]; }
  bt[0] = lf[0]; bt[1] = bt[0] + lf[1]; bt[2] = bt[1] + lf[2]; bt[3] = bt[2] + lf[3];
  const float m0 = p.in[I_STM][b * 4 + h];
  float gs[4], Mt[4], winit[4], emt[4];
  float G = -INFINITY;
#pragma unroll
  for (int t = 0; t < 4; ++t) {
    gs[t] = ip[t] - bt[t];
    G = fmaxf(G, gs[t]);
    Mt[t] = fmaxf(m0, G);
    winit[t] = expf(m0 - Mt[t]);
    emt[t] = expf(-(bt[t] + Mt[t]));
  }
  const float mnew = bt[3] + Mt[3];
  float wend[4];
#pragma unroll
  for (int s = 0; s < 4; ++s) wend[s] = expf(bt[3] - bt[s] + ip[s] - mnew);
  const float decay = expf(bt[3] + m0 - mnew);
  __syncthreads();
  {
    const int pr = tid >> 4, sub = tid & 15, t = pr >> 2, s = pr & 3;
    float a = 0.f;
#pragma unroll
    for (int j = 0; j < 8; ++j) a += qs[t * 128 + sub * 8 + j] * ksm[s * 128 + sub * 8 + j];
    a += __shfl_xor(a, 1); a += __shfl_xor(a, 2); a += __shfl_xor(a, 4); a += __shfl_xor(a, 8);
    if (sub == 0) qk[pr] = a;
    if (pr < 4) {
      float a2 = 0.f;
#pragma unroll
      for (int j = 0; j < 8; ++j) a2 += qs[pr * 128 + sub * 8 + j] * p.in[I_STN][(size_t)(b * 4 + h) * 128 + sub * 8 + j];
      a2 += __shfl_xor(a2, 1); a2 += __shfl_xor(a2, 2); a2 += __shfl_xor(a2, 4); a2 += __shfl_xor(a2, 8);
      if (sub == 0) qn[pr] = a2;
    }
  }
  for (int i = tid; i < 1024; i += 256) {
    const int dk = i >> 3, j = i & 7;
    qw[i] = (j < 4) ? qs[j * 128 + dk] : wend[j - 4] * ksm[(j - 4) * 128 + dk];
  }
  __syncthreads();
  float sw[4][4], den[4];
#pragma unroll
  for (int t = 0; t < 4; ++t) {
    float dsum = 0.f;
#pragma unroll
    for (int s = 0; s < 4; ++s) {
      sw[t][s] = (s <= t) ? qk[t * 4 + s] * expf(gs[s] - Mt[t]) : 0.f;
      dsum += sw[t][s];
    }
    den[t] = dsum + winit[t] * qn[t];
  }
  const int dv = tid;
  float vv[4];
#pragma unroll
  for (int s = 0; s < 4; ++s) {
    const float* pr = p.part + (size_t)(b * 4 + s) * 3072 + 2048 + h * 256 + dv;
    vv[s] = pr[0] + pr[(size_t)512 * 3072] + pr[(size_t)2 * 512 * 3072] + pr[(size_t)3 * 512 * 3072];
  }
  const float* __restrict__ C0 = p.in[I_STC] + (size_t)(b * 4 + h) * 128 * 256 + dv;
  float* __restrict__ C1 = p.out + O_CS + (size_t)(b * 4 + h) * 128 * 256 + dv;
  float qc[4] = {0.f, 0.f, 0.f, 0.f};
#pragma unroll 1
  for (int dk0 = 0; dk0 < 128; dk0 += 32) {
    float cb[32];
#pragma unroll
    for (int j = 0; j < 32; ++j) cb[j] = __builtin_nontemporal_load(C0 + (dk0 + j) * 256);
#pragma unroll
    for (int j = 0; j < 32; ++j) {
      const float c = cb[j];
      const float4 q4v = *(const float4*)(qw + (dk0 + j) * 8);
      const float4 k4v = *(const float4*)(qw + (dk0 + j) * 8 + 4);
      qc[0] += q4v.x * c; qc[1] += q4v.y * c; qc[2] += q4v.z * c; qc[3] += q4v.w * c;
      __builtin_nontemporal_store(decay * c + k4v.x * vv[0] + k4v.y * vv[1] + k4v.z * vv[2] + k4v.w * vv[3], C1 + (dk0 + j) * 256);
    }
  }
  float hh[4];
  float rs[8];
#pragma unroll
  for (int t = 0; t < 4; ++t) {
    float num = winit[t] * qc[t];
#pragma unroll
    for (int s = 0; s < 4; ++s) num += sw[t][s] * vv[s];
    hh[t] = num / fmaxf(fabsf(den[t]), emt[t]);
    rs[t] = hh[t]; rs[4 + t] = hh[t] * hh[t];
  }
#pragma unroll
  for (int i = 0; i < 8; ++i) rs[i] = wave_sum(rs[i]);
  if (lane == 0) {
#pragma unroll
    for (int i = 0; i < 8; ++i) red[wave * 8 + i] = rs[i];
  }
  __syncthreads();
  const float nw = p.in[I_MLNW][h * 256 + dv];
#pragma unroll
  for (int t = 0; t < 4; ++t) {
    const float s1 = red[t] + red[8 + t] + red[16 + t] + red[24 + t];
    const float s2 = red[4 + t] + red[12 + t] + red[20 + t] + red[28 + t];
    const float mu = s1 * (1.f / 256.f);
    const float var = fmaxf(s2 * (1.f / 256.f) - mu * mu, 0.f);
    const float* pro = p.part + (size_t)(b * 4 + t) * 3072 + 1024 + h * 256 + dv;
    const float o = pro[0] + pro[(size_t)512 * 3072] + pro[(size_t)2 * 512 * 3072] + pro[(size_t)3 * 512 * 3072];
    p.H[(size_t)(tok0 + t) * 1024 + h * 256 + dv] = f2bf((hh[t] - mu) * rsqrtf(var + LN_EPS) * nw * sigmoidf_(o));
  }
  if (tid < 128) {
    float nn = decay * p.in[I_STN][(size_t)(b * 4 + h) * 128 + tid];
#pragma unroll
    for (int s = 0; s < 4; ++s) nn += wend[s] * ksm[s * 128 + tid];
    p.out[O_NS + (size_t)(b * 4 + h) * 128 + tid] = nn;
  }
  if (tid == 0) p.out[O_MS + b * 4 + h] = mnew;
  __syncthreads();
}

__device__ __forceinline__ void mlstm_scan_phase(PRef p, char* smem, bool dryrun) {
  const int tid = vq_tid();
  float* fa = (float*)smem;
  float* fu = fa + 128;
  float* aB = fu + 128;
  float* aM = aB + 128;
  for (int w = vq_bid(); w < 256; w += vq_gdim()) {
    const int bh = w >> 5, sub = w & 31;
    if (tid < 128) { aB[tid] = p.ab[(bh * 128 + tid) * 2]; aM[tid] = p.ab[(bh * 128 + tid) * 2 + 1]; }
    __syncthreads();
    if (tid == 0) {
      float m = 0.f;
      for (int k = 0; k < 128; ++k) {
        const float Bk = aB[k], ml = aM[k];
        const float mn = fmaxf(Bk + m, ml);
        fa[k] = __expf(Bk + m - mn); fu[k] = __expf(ml - mn);
        aB[k] = m;
        m = mn;
      }
      aM[0] = m;
    }
    __syncthreads();
    if (sub == 0) {
      if (tid < 128) p.mk[bh * 129 + tid] = aB[tid];
      if (tid == 0) { p.mk[bh * 129 + 128] = aM[0]; p.out[O_MP + bh] = aM[0]; }
    }
    const int e4 = sub * 256 + tid;
    float c0 = 0.f, c1 = 0.f, c2 = 0.f, c3 = 0.f;
    bf16* base = p.uck + (size_t)bh * 128 * 32768 + (size_t)e4 * 4;
    for (int k0 = 0; k0 < 128; k0 += 16) {
      uint2 u[16];
#pragma unroll
      for (int j = 0; j < 16; ++j) u[j] = *(const uint2*)(base + (size_t)(k0 + j) * 32768);
#pragma unroll
      for (int j = 0; j < 16; ++j) {
        uint2 o; o.x = pack2(c0, c1); o.y = pack2(c2, c3);
        if (!dryrun) *(uint2*)(base + (size_t)(k0 + j) * 32768) = o;
        const float a = fa[k0 + j], f = fu[k0 + j];
        c0 = a * c0 + f * __uint_as_float(u[j].x << 16);
        c1 = a * c1 + f * __uint_as_float(u[j].x & 0xffff0000u);
        c2 = a * c2 + f * __uint_as_float(u[j].y << 16);
        c3 = a * c3 + f * __uint_as_float(u[j].y & 0xffff0000u);
      }
    }
    {
      const int e = e4 * 4, dv = e >> 7, dk = e & 127;
      float* o = p.out + O_CP + (size_t)bh * 32768;
      o[(dk + 0) * 256 + dv] = c0; o[(dk + 1) * 256 + dv] = c1; o[(dk + 2) * 256 + dv] = c2; o[(dk + 3) * 256 + dv] = c3;
    }
    if (sub == 1 && tid < 128) {
      float n = 0.f;
      for (int k0 = 0; k0 < 128; k0 += 16) {
        float un[16];
#pragma unroll
        for (int j = 0; j < 16; ++j) un[j] = p.un[(size_t)(bh * 128 + k0 + j) * 128 + tid];
#pragma unroll
        for (int j = 0; j < 16; ++j) {
          p.nk[(size_t)(bh * 128 + k0 + j) * 128 + tid] = n;
          n = fa[k0 + j] * n + fu[k0 + j] * un[j];
        }
      }
      p.out[O_NP + bh * 128 + tid] = n;
    }
    __syncthreads();
  }
}

__device__ __forceinline__ void mlstm_C_item(PRef p, int item, char* smem, bool dryrun) {
  const int tid = vq_tid(), lane = tid & 63, wave = __builtin_amdgcn_readfirstlane(tid >> 6), l15 = lane & 15, q4 = lane >> 4;
  const int bh = item >> 7, c = item & 127, b = bh >> 2, h = bh & 3;
  const int tok0 = b * SEQ + c * 64;
  bf16* Sb = (bf16*)smem;
  float* gsv = (float*)(smem + 9216);
  float* Mtv = gsv + 64;
  float* wiv = Mtv + 64;
  float* emv = wiv + 64;
  float* red = emv + 64;
  const float mk = p.mk[bh * 129 + c];
  if (wave == 0) {
    const float lf = p.gates[(size_t)(tok0 + lane) * 8 + 4 + h], ip = p.gates[(size_t)(tok0 + lane) * 8 + h];
    const float bt = scan_add(lf, lane);
    const float g = ip - bt;
    const float G = scan_max(g, lane);
    const float M = fmaxf(mk, G);
    gsv[lane] = g; Mtv[lane] = M; wiv[lane] = expf(mk - M); emv[lane] = expf(-(bt + M));
  }
  __syncthreads();
  {
    f32x4 sacc[4];
#pragma unroll
    for (int i = 0; i < 4; ++i) sacc[i] = (f32x4){0.f, 0.f, 0.f, 0.f};
#pragma unroll
    for (int ks = 0; ks < 4; ++ks) {
      const bf16x8 af = *(const bf16x8*)(p.proj + (size_t)(tok0 + wave * 16 + l15) * 2048 + h * 128 + ks * 32 + q4 * 8);
#pragma unroll
      for (int sb = 0; sb < 4; ++sb) {
        if (sb <= wave) {
          const bf16x8 bfr = *(const bf16x8*)(p.proj + (size_t)(tok0 + sb * 16 + l15) * 2048 + 512 + h * 128 + ks * 32 + q4 * 8);
          sacc[sb] = MFMA(af, bfr, sacc[sb]);
        }
      }
    }
#pragma unroll
    for (int sb = 0; sb < 4; ++sb) {
      const int s = sb * 16 + l15;
      const float g = gsv[s];
#pragma unroll
      for (int jj = 0; jj < 4; ++jj) {
        const int t = wave * 16 + q4 * 4 + jj;
        const float v = (s <= t) ? sacc[sb][jj] * __expf(g - Mtv[t]) : 0.f;
        Sb[t * 72 + s] = f2bf(v);
      }
    }
  }
  __syncthreads();
  f32x4 acc[4][4], accd[4];
#pragma unroll
  for (int i = 0; i < 4; ++i) {
    accd[i] = (f32x4){0.f, 0.f, 0.f, 0.f};
#pragma unroll
    for (int j = 0; j < 4; ++j) acc[i][j] = (f32x4){0.f, 0.f, 0.f, 0.f};
  }
  const bf16* __restrict__ ckb = p.uck + ((size_t)(bh * 128 + c) * 256) * 128;
  const float* __restrict__ nkp = p.nk + (size_t)(bh * 128 + c) * 128;
  const bf16* __restrict__ projr = p.proj;
  bf16x8 vfr[2][4];
#pragma unroll
  for (int ks = 0; ks < 2; ++ks)
#pragma unroll
    for (int nb = 0; nb < 4; ++nb) vfr[ks][nb] = *(const bf16x8*)(p.vt + ((size_t)(bh * 256 + wave * 64 + nb * 16 + l15)) * SEQ + c * 64 + ks * 32 + q4 * 8);
#pragma unroll 2
  for (int ks = 0; ks < 4; ++ks) {
    bf16x8 bfr[4], nfr;
#pragma unroll
    for (int nb = 0; nb < 4; ++nb) bfr[nb] = *(const bf16x8*)(ckb + (size_t)(wave * 64 + nb * 16 + l15) * 128 + ks * 32 + q4 * 8);
#pragma unroll
    for (int j = 0; j < 8; ++j) nfr[j] = (l15 == 0) ? (short)f2bf(nkp[ks * 32 + q4 * 8 + j]) : (short)0;
#pragma unroll
    for (int tb = 0; tb < 4; ++tb) {
      const bf16x8 af = *(const bf16x8*)(projr + (size_t)(tok0 + tb * 16 + l15) * 2048 + h * 128 + ks * 32 + q4 * 8);
#pragma unroll
      for (int nb = 0; nb < 4; ++nb) acc[tb][nb] = MFMA(af, bfr[nb], acc[tb][nb]);
      accd[tb] = MFMA(af, nfr, accd[tb]);
    }
  }
#pragma unroll
  for (int tb = 0; tb < 4; ++tb)
#pragma unroll
    for (int jj = 0; jj < 4; ++jj) {
      const float wi = wiv[tb * 16 + q4 * 4 + jj];
      accd[tb][jj] *= wi;
#pragma unroll
      for (int nb = 0; nb < 4; ++nb) acc[tb][nb][jj] *= wi;
    }
  bf16x8 ones;
#pragma unroll
  for (int j = 0; j < 8; ++j) ones[j] = (l15 == 0) ? (short)0x3F80 : (short)0;
#pragma unroll
  for (int ks = 0; ks < 2; ++ks) {
#pragma unroll
    for (int tb = 0; tb < 4; ++tb) {
      const bf16x8 af = *(const bf16x8*)(Sb + (tb * 16 + l15) * 72 + ks * 32 + q4 * 8);
#pragma unroll
      for (int nb = 0; nb < 4; ++nb) acc[tb][nb] = MFMA(af, vfr[ks][nb], acc[tb][nb]);
      accd[tb] = MFMA(af, ones, accd[tb]);
    }
  }
#pragma unroll
  for (int tb = 0; tb < 4; ++tb)
#pragma unroll
    for (int jj = 0; jj < 4; ++jj) {
      const int t = tb * 16 + q4 * 4 + jj;
      const float den = __shfl(accd[tb][jj], lane & 48);
      const float inv = 1.f / fmaxf(fabsf(den), emv[t]);
      float s1 = 0.f, s2 = 0.f;
#pragma unroll
      for (int nb = 0; nb < 4; ++nb) { const float hv = acc[tb][nb][jj] * inv; acc[tb][nb][jj] = hv; s1 += hv; s2 += hv * hv; }
      s1 += __shfl_xor(s1, 1); s1 += __shfl_xor(s1, 2); s1 += __shfl_xor(s1, 4); s1 += __shfl_xor(s1, 8);
      s2 += __shfl_xor(s2, 1); s2 += __shfl_xor(s2, 2); s2 += __shfl_xor(s2, 4); s2 += __shfl_xor(s2, 8);
      if (l15 == 0) { red[(wave * 64 + t) * 2] = s1; red[(wave * 64 + t) * 2 + 1] = s2; }
    }
  __syncthreads();
  float nwv[4];
#pragma unroll
  for (int nb = 0; nb < 4; ++nb) nwv[nb] = p.in[I_MLNW][h * 256 + wave * 64 + nb * 16 + l15];
  bf16* __restrict__ yb = p.H;
#pragma unroll
  for (int tb = 0; tb < 4; ++tb) {
#pragma unroll
    for (int jj = 0; jj < 4; ++jj) {
      const int t = tb * 16 + q4 * 4 + jj;
      const float s1 = red[t * 2] + red[(64 + t) * 2] + red[(128 + t) * 2] + red[(192 + t) * 2];
      const float s2 = red[t * 2 + 1] + red[(64 + t) * 2 + 1] + red[(128 + t) * 2 + 1] + red[(192 + t) * 2 + 1];
      const float mu = s1 * (1.f / 256.f);
      const float rstd = rsqrtf(fmaxf(s2 * (1.f / 256.f) - mu * mu, 0.f) + LN_EPS);
#pragma unroll
      for (int nb = 0; nb < 4; ++nb) {
        const int dv = wave * 64 + nb * 16 + l15;
        const float o = bf2f(projr[(size_t)(tok0 + t) * 2048 + 1024 + h * 256 + dv]);
        const float yv = (acc[tb][nb][jj] - mu) * rstd * nwv[nb] * sigmoidf_(o);
        if (!dryrun) yb[(size_t)(tok0 + t) * 1024 + h * 256 + dv] = f2bf(yv);
        else if (yv == 1.2345e30f) p.mods[0] = 1.f;
      }
    }
  }
  __syncthreads();
}

__device__ __forceinline__ void attn_prompt_item(PRef p, int item, char* smem) {
  const int tid = vq_tid(), lane = tid & 63, wave = __builtin_amdgcn_readfirstlane(tid >> 6), l15 = lane & 15, q4 = lane >> 4;
  const int b = item >> 8, kvh = (item >> 6) & 3, nb = item & 63;
  const int qh = kvh * 4 + wave;
  const float sink = p.in[I_SINKS][qh];
  bf16* Pb = (bf16*)smem + wave * 16 * 168;
  const bf16x8 zero8 = (bf16x8){0, 0, 0, 0, 0, 0, 0, 0};
  for (int qt = 0; qt < 8; ++qt) {
    const int q0 = nb * 128 + qt * 16;
    bf16x8 qf[2];
#pragma unroll
    for (int ks = 0; ks < 2; ++ks) qf[ks] = *(const bf16x8*)(p.q + (size_t)(b * SEQ + q0 + l15) * D + qh * 64 + ks * 32 + q4 * 8);
    bf16x8 vfa[5][4];
#pragma unroll
    for (int ks = 0; ks < 5; ++ks) {
      const int kidx = q0 - 128 + ks * 32 + q4 * 8;
      const bool ok = (kidx >= 0) && !(ks == 4 && q4 >= 2);
#pragma unroll
      for (int db = 0; db < 4; ++db) {
        vfa[ks][db] = zero8;
        if (ok) vfa[ks][db] = *(const bf16x8*)(p.vta + ((size_t)((b * 4 + kvh) * 64 + db * 16 + l15)) * SEQ + kidx);
      }
    }
    f32x4 s[9];
#pragma unroll
    for (int kb = 0; kb < 9; ++kb) {
      s[kb] = (f32x4){0.f, 0.f, 0.f, 0.f};
      const int key0 = q0 - 128 + kb * 16;
      if (key0 >= 0) {
#pragma unroll
        for (int ks = 0; ks < 2; ++ks) {
          const bf16x8 kf = *(const bf16x8*)(p.ks + (size_t)(b * SEQ + key0 + l15) * 256 + kvh * 64 + ks * 32 + q4 * 8);
          s[kb] = MFMA(qf[ks], kf, s[kb]);
        }
      }
    }
    float mx[4], sum[4];
#pragma unroll
    for (int jj = 0; jj < 4; ++jj) {
      const int r = q4 * 4 + jj;
      float m = -INFINITY;
#pragma unroll
      for (int kb = 0; kb < 9; ++kb) {
        const int key0 = q0 - 128 + kb * 16;
        bool valid = key0 >= 0;
        if (kb == 0) valid = valid && (l15 > r);
        if (kb == 8) valid = valid && (l15 <= r);
        const float v = valid ? s[kb][jj] : -INFINITY;
        s[kb][jj] = v;
        m = fmaxf(m, v);
      }
      m = fmaxf(m, __shfl_xor(m, 1)); m = fmaxf(m, __shfl_xor(m, 2)); m = fmaxf(m, __shfl_xor(m, 4)); m = fmaxf(m, __shfl_xor(m, 8));
      m = fmaxf(m, sink);
      float sm = 0.f;
#pragma unroll
      for (int kb = 0; kb < 9; ++kb) {
        const float e = __expf(s[kb][jj] - m);
        sm += e;
        Pb[r * 168 + kb * 16 + l15] = f2bf(e);
      }
      Pb[r * 168 + 144 + l15] = 0;
      sm += __shfl_xor(sm, 1); sm += __shfl_xor(sm, 2); sm += __shfl_xor(sm, 4); sm += __shfl_xor(sm, 8);
      mx[jj] = m; sum[jj] = sm + __expf(sink - m);
    }
    __syncthreads();
    f32x4 o[4];
#pragma unroll
    for (int db = 0; db < 4; ++db) o[db] = (f32x4){0.f, 0.f, 0.f, 0.f};
#pragma unroll
    for (int ks = 0; ks < 5; ++ks) {
      const bf16x8 pf = *(const bf16x8*)(Pb + l15 * 168 + ks * 32 + q4 * 8);
#pragma unroll
      for (int db = 0; db < 4; ++db) o[db] = MFMA(pf, vfa[ks][db], o[db]);
    }
#pragma unroll
    for (int db = 0; db < 4; ++db)
#pragma unroll
      for (int jj = 0; jj < 4; ++jj) {
        const int r = q4 * 4 + jj;
        p.att[(size_t)(b * SEQ + q0 + r) * D + qh * 64 + db * 16 + l15] = f2bf(o[db][jj] / sum[jj]);
      }
    __syncthreads();
  }
}

__device__ __forceinline__ void attn_sample_item(PRef p, int item, char* smem) {
  const int tid = vq_tid();
  const int b = item >> 2, kvh = item & 3;
  float* qs = (float*)smem;
  float* sc = qs + 1024;
  float* rinv = sc + 16 * 132;
  const float* ck = p.in[I_CK]; const float* cv = p.in[I_CV];
  float* wk = p.out + O_WKS; float* wv = p.out + O_WVS;
  for (int i = tid; i < 124 * 16; i += 256) {
    const int r = i >> 4, c4 = (i & 15) * 4;
    { const float4 t4 = *(const float4*)(ck + ((size_t)(b * 128 + r + 4) * 4 + kvh) * 64 + c4);
      __builtin_nontemporal_store((f32x4){t4.x, t4.y, t4.z, t4.w}, (f32x4*)(wk + ((size_t)(b * 128 + r) * 4 + kvh) * 64 + c4)); }
    { const float4 t4 = *(const float4*)(cv + ((size_t)(b * 128 + r + 4) * 4 + kvh) * 64 + c4);
      __builtin_nontemporal_store((f32x4){t4.x, t4.y, t4.z, t4.w}, (f32x4*)(wv + ((size_t)(b * 128 + r) * 4 + kvh) * 64 + c4)); }
  }
  for (int i = tid; i < 1024; i += 256) {
    const int r = i >> 6, d = i & 63, t = r >> 2, g = r & 3;
    const int col = (kvh * 4 + g) * 64 + d;
    const float* pr = p.part + (size_t)(b * 4 + t) * 1024;
    float v = pr[col] + pr[(size_t)512 * 1024 + col] + pr[(size_t)2 * 512 * 1024 + col] + pr[(size_t)3 * 512 * 1024 + col];
    if (d < 16) {
      const int pc = d < 8 ? col + 8 : col - 8;
      const float v2 = pr[pc] + pr[(size_t)512 * 1024 + pc] + pr[(size_t)2 * 512 * 1024 + pc] + pr[(size_t)3 * 512 * 1024 + pc];
      const float2 cs = p.rot[(8192 + t) * 8 + (d & 7)];
      v = d < 8 ? v * cs.x - v2 * cs.y : v * cs.x + v2 * cs.y;
    }
    qs[i] = v * 0.125f;
  }
  __syncthreads();
  const int r = tid >> 4, sub = tid & 15, t = r >> 2, g = r & 3;
  const float sink = p.in[I_SINKS][kvh * 4 + g];
  float lmax = -INFINITY;
  for (int i = 0; i < 9; ++i) {
    const int key = sub + 16 * i;
    if (key < 132) {
      const float* kp = key < 128 ? ck + ((size_t)(b * 128 + key) * 4 + kvh) * 64 : wk + ((size_t)(b * 128 + 124 + key - 128) * 4 + kvh) * 64;
      float a = 0.f;
#pragma unroll
      for (int d4 = 0; d4 < 16; ++d4) {
        const float4 kv = *(const float4*)(kp + d4 * 4);
        const float4 qv = *(const float4*)(qs + r * 64 + d4 * 4);
        a += kv.x * qv.x + kv.y * qv.y + kv.z * qv.z + kv.w * qv.w;
      }
      const bool valid = key < 128 ? (key > t) : ((key - 128) <= t);
      a = valid ? a : -INFINITY;
      sc[r * 132 + key] = a;
      lmax = fmaxf(lmax, a);
    }
  }
  lmax = fmaxf(lmax, __shfl_xor(lmax, 1)); lmax = fmaxf(lmax, __shfl_xor(lmax, 2)); lmax = fmaxf(lmax, __shfl_xor(lmax, 4)); lmax = fmaxf(lmax, __shfl_xor(lmax, 8));
  lmax = fmaxf(lmax, sink);
  float lsum = 0.f;
  for (int i = 0; i < 9; ++i) {
    const int key = sub + 16 * i;
    if (key < 132) {
      const float e = __expf(sc[r * 132 + key] - lmax);
      sc[r * 132 + key] = e;
      lsum += e;
    }
  }
  lsum += __shfl_xor(lsum, 1); lsum += __shfl_xor(lsum, 2); lsum += __shfl_xor(lsum, 4); lsum += __shfl_xor(lsum, 8);
  if (sub == 0) rinv[r] = 1.f / (lsum + __expf(sink - lmax));
  __syncthreads();
  float4 o = make_float4(0.f, 0.f, 0.f, 0.f);
  {
    const float* vb0 = cv + ((size_t)(b * 128) * 4 + kvh) * 64 + sub * 4;
#pragma unroll 16
    for (int key = 0; key < 128; ++key) {
      const float4 vv = *(const float4*)(vb0 + (size_t)key * 256);
      const float pw = sc[r * 132 + key];
      o.x += pw * vv.x; o.y += pw * vv.y; o.z += pw * vv.z; o.w += pw * vv.w;
    }
    const float* vb1 = wv + ((size_t)(b * 128 + 124) * 4 + kvh) * 64 + sub * 4;
#pragma unroll
    for (int key = 0; key < 4; ++key) {
      const float4 vv = *(const float4*)(vb1 + (size_t)key * 256);
      const float pw = sc[r * 132 + 128 + key];
      o.x += pw * vv.x; o.y += pw * vv.y; o.z += pw * vv.z; o.w += pw * vv.w;
    }
  }
  const float ri = rinv[r];
  uint2 ov; ov.x = pack2(o.x * ri, o.y * ri); ov.y = pack2(o.z * ri, o.w * ri);
  *(uint2*)(p.att + (size_t)(TP + b * 4 + t) * D + (kvh * 4 + g) * 64 + sub * 4) = ov;
  __syncthreads();
}


#ifdef SELFCHECK
__device__ __forceinline__ unsigned dhash(unsigned a, unsigned b) { unsigned h = a * 2654435761u + b * 40503u + 12345u; h ^= h >> 15; h *= 2246822519u; h ^= h >> 13; return h; }
__device__ __forceinline__ bool dbad(float got, float want, float tol, float flo) { return !(fabsf(got - want) <= tol * (fabsf(want) + flo)); }
__device__ __forceinline__ float ddot(const bf16* a, const float* w, int ldw, int K) { float s = 0.f; for (int k = 0; k < K; ++k) s += bf2f(a[k]) * w[(size_t)k * ldw]; return s; }
__device__ __forceinline__ void dfail(PRef p, int code) { atomicMin(p.dbg, code); }
__device__ __forceinline__ void stashX(PRef p, int salt) {
  const int tid = threadIdx.x; const unsigned h = dhash(tid, salt);
  const int tok = (tid & 1) ? TP + (h % 512) : (h % TP); const int col = (h >> 12) % 1024;
  p.stash[tid] = p.out[(size_t)tok * D + col];
}
__device__ void selfcheck(PRef p, int ph, char* dsm) {
  const int tid = threadIdx.x;
  const unsigned h = dhash(tid, ph);
  const int tok = (tid & 1) ? TP + (h % 512) : (h % TP);
  const int brow = brow_of(tok);
  const float* mrow = p.mods + (size_t)brow * MODW;
  const int layer = ph >= 15 ? 1 : 0; const int lo = layer * 9216;
  if (ph == 0) {
    WDesc w; int di = tid & 15;
    w.src = p.wd[0].src; w.dst = p.wd[0].dst; w.K = p.wd[0].K; w.N = p.wd[0].N; w.ld = p.wd[0].ld;
#pragma unroll
    for (int i = 1; i < 16; ++i) if (di == i) { w.src = p.wd[i].src; w.dst = p.wd[i].dst; w.K = p.wd[i].K; w.N = p.wd[i].N; w.ld = p.wd[i].ld; }
    const int n = h % w.N, k = (h >> 8) % w.K;
    if (w.dst[(size_t)n * w.K + k] != f2bf(w.src[(size_t)k * w.ld + n])) dfail(p, 1);
    const int pos = h % 8196, fi = tid & 7;
    const float ang = (float)((double)pos * p.inv_freq[fi]);
    const float2 cs = p.rot[pos * 8 + fi];
    if (fabsf(cs.x - cosf(ang)) > 2e-3f || fabsf(cs.y - sinf(ang)) > 2e-3f) dfail(p, 26);
  } else if (ph == 1) {
    const int br = tid % NBR, col = h % MODW;
    const float* c = br < 2 ? p.in[I_CP] + br * 1024 : p.in[I_CS] + (br - 2) * 1024;
    const float* W = col < 9216 ? p.in[I_ADAW] + col : col < 18432 ? p.in[I_ADAW] + (size_t)1024 * 9216 + (col - 9216) : p.in[I_KVADAW] + (col - 18432);
    const int ld = col < 18432 ? 9216 : 2048;
    float s = col < 18432 ? p.in[I_ADAB][col] : p.in[I_KVADAB][col - 18432];
    for (int k = 0; k < 1024; ++k) { float v = c[k]; v = v / (1.f + expf(-v)); s += v * W[(size_t)k * ld]; }
    if (dbad(p.mods[(size_t)br * MODW + col], s, 0.02f, 0.5f)) dfail(p, 2);
  } else if (ph == 2) {
    const int col = (h >> 12) % 1024;
    const float x = tok < TP ? p.in[I_XP][(size_t)tok * D + col] : p.in[I_XS][(size_t)(tok - TP) * D + col];
    if (p.out[(size_t)tok * D + col] != x) dfail(p, 3);
    if (dbad(bf2f(p.H[(size_t)tok * D + col]), x * (1.f + mrow[1024 + col]) + mrow[col], 0.01f, 0.02f)) dfail(p, 3);
  } else if (ph == 3 || ph == 12 || ph == 15 || ph == 22) {
    const int j = (h >> 12) % F;
    const float* W = (ph == 3 ? p.in[I_F1U] : ph == 12 ? p.in[I_F2U] : ph == 15 ? p.in[I_F1U] + (size_t)1024 * 5632 : p.in[I_F2U] + (size_t)1024 * 5632);
    const float a = ddot(p.H + (size_t)tok * D, W + j, 5632, 1024), u = ddot(p.H + (size_t)tok * D, W + F + j, 5632, 1024);
    if (dbad(bf2f(p.hid[(size_t)tok * F + j]), a / (1.f + expf(-a)) * u, 0.03f, 1.0f)) dfail(p, ph + 1);
    if (ph == 15) {
      const int col = (h >> 5) % 512;
      float v = ddot(p.hkv + (size_t)tok * D, p.in[I_KVW] + col, 512, 1024);
      const int cc = col & 255, kvh = cc >> 6, d = cc & 63;
      if (col < 256 && d < 16) {
        const int pcol = d < 8 ? col + 8 : col - 8;
        const float v2 = ddot(p.hkv + (size_t)tok * D, p.in[I_KVW] + pcol, 512, 1024);
        const float ang = (float)((double)pos_of(tok) * p.inv_freq[d & 7]);
        v = d < 8 ? v * cosf(ang) - v2 * sinf(ang) : v * cosf(ang) + v2 * sinf(ang);
      }
      float got;
      if (col < 256) got = bf2f(p.ks[(size_t)tok * 256 + cc]);
      else if (tok < TP) got = bf2f(p.vta[((size_t)((tok >> 13) * 4 + kvh) * 64 + d) * SEQ + (tok & 8191)]);
      else got = p.out[O_WVS + ((size_t)(((tok - TP) >> 2) * 128 + 124 + ((tok - TP) & 3)) * 4 + kvh) * 64 + d];
      if (dbad(got, v, 0.03f, 1.0f)) dfail(p, 27);
      if (tok >= TP) {
        const float g2 = p.out[(col < 256 ? O_WKS : O_WVS) + ((size_t)(((tok - TP) >> 2) * 128 + 124 + ((tok - TP) & 3)) * 4 + kvh) * 64 + d];
        if (dbad(g2, v, 0.03f, 1.0f)) dfail(p, 28);
      }
    }
    stashX(p, ph + 1);
  } else if (ph == 4 || ph == 13 || ph == 16 || ph == 23 || ph == 10 || ph == 20) {
    const unsigned h2 = dhash(tid, ph); const int tk = (tid & 1) ? TP + (h2 % 512) : (h2 % TP); const int col = (h2 >> 12) % 1024;
    const float* mr = p.mods + (size_t)brow_of(tk) * MODW;
    float acc, gate, wgt;
    if (ph == 10) { acc = ddot(p.proj + (size_t)tk * 2048 + 1024, p.in[I_MLWOUT] + col, 1024, 1024); gate = mr[lo + 5 * 1024 + col]; wgt = 1.f; }
    else if (ph == 20) { acc = ddot(p.att + (size_t)tk * D, p.in[I_ATTWO] + col, 1024, 1024); gate = mr[lo + 5 * 1024 + col]; wgt = 1.f; }
    else {
      const float* W = (ph == 4 ? p.in[I_F1D] : ph == 13 ? p.in[I_F2D] : ph == 16 ? p.in[I_F1D] + (size_t)F * 1024 : p.in[I_F2D] + (size_t)F * 1024);
      acc = ddot(p.hid + (size_t)tk * F, W + col, 1024, F); gate = mr[lo + ((ph == 4 || ph == 16) ? 2 : 8) * 1024 + col]; wgt = 0.5f;
    }
    const float want = ALPHA * p.stash[tid] + wgt * gate * acc;
    if (dbad(p.out[(size_t)tk * D + col], want, 0.02f, 1.0f)) dfail(p, ph + 1);
  } else if (ph == 5 || ph == 11 || ph == 14 || ph == 17 || ph == 21 || ph == 24) {
    const int j = (ph == 5 || ph == 17) ? 0 : (ph == 11 || ph == 21) ? 1 : 2;
    const float* lg = p.in[I_LNG] + (layer * 3 + j) * D; const float* lb = p.in[I_LNB] + (layer * 3 + j) * D;
    float s1 = 0.f, s2 = 0.f;
    for (int c = 0; c < 1024; ++c) { const float z = (p.out[(size_t)tok * D + c] - lb[c]) / lg[c]; s1 += z; s2 += z * z; }
    s1 *= (1.f / 1024.f); s2 = s2 * (1.f / 1024.f) - s1 * s1;
    if (fabsf(s1) > 0.01f || fabsf(s2 - 1.f) > 0.02f) dfail(p, ph + 1);
    const int hoff = ph == 5 ? 3072 : ph == 11 ? 6144 : ph == 14 ? 9216 : ph == 17 ? 9216 + 3072 : ph == 21 ? 9216 + 6144 : -1;
    const int col = (h >> 12) % 1024;
    const float x = p.out[(size_t)tok * D + col];
    if (hoff >= 0 && dbad(bf2f(p.H[(size_t)tok * D + col]), x * (1.f + mrow[hoff + 1024 + col]) + mrow[hoff + col], 0.01f, 0.02f)) dfail(p, 29);
    if (ph == 14 && dbad(bf2f(p.hkv[(size_t)tok * D + col]), x * (1.f + mrow[18432 + 1024 + col]) + mrow[18432 + col], 0.01f, 0.02f)) dfail(p, 30);
    if (ph == 5) {
      const int gi = tid & 7; float s = p.in[I_MLBG][gi];
      for (int c = 0; c < 1024; ++c) s += (p.out[(size_t)tok * D + c] * (1.f + mrow[3072 + 1024 + c]) + mrow[3072 + c]) * p.in[I_MLWIN][(size_t)c * 3080 + 3072 + gi];
      if (gi >= 4) s = -log1pf(expf(-s));
      if (dbad(p.gates[(size_t)tok * 8 + gi], s, 0.01f, 0.01f)) dfail(p, 31);
    }
    stashX(p, ph == 5 ? 10 : ph == 17 ? 20 : ph + 1);
  } else if (ph == 6) {
    const int col = (h >> 12) % 3072;
    float v = ddot(p.H + (size_t)tok * D, p.in[I_MLWIN] + col, 3080, 1024);
    if (col >= 512 && col < 1024) v *= 0.08838834764831845f;
    float got;
    if (col < 1024) got = bf2f(p.proj[(size_t)tok * 2048 + col]);
    else if (col >= 2048) got = bf2f(p.proj[(size_t)tok * 2048 + col - 1024]);
    else if (tok >= TP) got = bf2f(p.vsamp[(size_t)(tok - TP) * 1024 + col - 1024]);
    else { const int c2 = col - 1024; got = bf2f(p.vt[((size_t)((tok >> 13) * 4 + (c2 >> 8)) * 256 + (c2 & 255)) * SEQ + (tok & 8191)]); }
    if (dbad(got, v, 0.03f, 0.5f)) dfail(p, 7);
    if (col >= 512 && col < 1024 && tok < TP) {
      const int c2 = col - 512;
      if (dbad(bf2f(p.kt[((size_t)((tok >> 13) * 4 + (c2 >> 7)) * 128 + (c2 & 127)) * SEQ + (tok & 8191)]), v, 0.03f, 0.5f)) dfail(p, 32);
    }
  } else if (ph == 7) {
    {
      const int bh = h & 7, c = (h >> 3) & 127, dv = (h >> 10) & 255, dk = (h >> 18) & 127, b = bh >> 2, hh = bh & 3;
      const int tok0 = b * SEQ + c * 64;
      float B = 0.f;
      for (int s = 0; s < 64; ++s) B += p.gates[(size_t)(tok0 + s) * 8 + 4 + hh];
      float bs = 0.f, ml = -INFINITY;
      for (int s = 0; s < 64; ++s) { bs += p.gates[(size_t)(tok0 + s) * 8 + 4 + hh]; ml = fmaxf(ml, B - bs + p.gates[(size_t)(tok0 + s) * 8 + hh]); }
      bs = 0.f; float u = 0.f, un = 0.f;
      for (int s = 0; s < 64; ++s) {
        bs += p.gates[(size_t)(tok0 + s) * 8 + 4 + hh];
        const float w = expf(B - bs + p.gates[(size_t)(tok0 + s) * 8 + hh] - ml);
        const float k = bf2f(p.proj[(size_t)(tok0 + s) * 2048 + 512 + hh * 128 + dk]);
        u += w * k * bf2f(p.vt[((size_t)(bh * 256 + dv)) * SEQ + c * 64 + s]); un += w * k;
      }
      if (dbad(p.ab[(bh * 128 + c) * 2], B, 1e-3f, 1e-2f) || dbad(p.ab[(bh * 128 + c) * 2 + 1], ml, 1e-3f, 1e-2f)) dfail(p, 33);
      if (dbad(bf2f(p.uck[((size_t)((bh * 128 + c) * 256 + dv)) * 128 + dk]), u, 0.03f, 0.05f)) dfail(p, 8);
      if (dbad(p.un[(size_t)(bh * 128 + c) * 128 + dk], un, 0.03f, 0.1f)) dfail(p, 34);
    }
    {
      const int b = (h >> 4) & 127, hh = h & 3, dk = (h >> 11) & 127, dv = (h >> 18) & 255;
      const int tok0 = TP + b * 4;
      float lf[4], ip[4], bt[4];
#pragma unroll
      for (int t = 0; t < 4; ++t) { ip[t] = p.gates[(size_t)(tok0 + t) * 8 + hh]; lf[t] = p.gates[(size_t)(tok0 + t) * 8 + 4 + hh]; }
      bt[0] = lf[0]; bt[1] = bt[0] + lf[1]; bt[2] = bt[1] + lf[2]; bt[3] = bt[2] + lf[3];
      const float m0 = p.in[I_STM][b * 4 + hh];
      float mt3 = bt[3] + m0;
#pragma unroll
      for (int s = 0; s < 4; ++s) mt3 = fmaxf(mt3, bt[3] - bt[s] + ip[s]);
      float cn = expf(bt[3] + m0 - mt3) * p.in[I_STC][((size_t)(b * 4 + hh) * 128 + dk) * 256 + dv];
      float nn = expf(bt[3] + m0 - mt3) * p.in[I_STN][(size_t)(b * 4 + hh) * 128 + dk];
#pragma unroll
      for (int s = 0; s < 4; ++s) {
        const float we = expf(bt[3] - bt[s] + ip[s] - mt3);
        const float k = bf2f(p.proj[(size_t)(tok0 + s) * 2048 + 512 + hh * 128 + dk]);
        cn += we * k * bf2f(p.vsamp[(size_t)(b * 4 + s) * 1024 + hh * 256 + dv]); nn += we * k;
      }
      if (dbad(p.out[O_CS + ((size_t)(b * 4 + hh) * 128 + dk) * 256 + dv], cn, 0.02f, 0.01f)) dfail(p, 35);
      if (dbad(p.out[O_NS + (size_t)(b * 4 + hh) * 128 + dk], nn, 0.02f, 0.01f)) dfail(p, 36);
      if (dbad(p.out[O_MS + b * 4 + hh], mt3, 1e-3f, 1e-2f)) dfail(p, 37);
    }
  } else if (ph == 8) {
    const int bh = h & 7, k = (h >> 3) & 127, d = (h >> 10) & 127;
    float m = 0.f, n = 0.f;
    for (int j = 0; j < k; ++j) {
      const float Bj = p.ab[(bh * 128 + j) * 2], ml = p.ab[(bh * 128 + j) * 2 + 1];
      const float mn = fmaxf(Bj + m, ml);
      n = expf(Bj + m - mn) * n + expf(ml - mn) * p.un[(size_t)(bh * 128 + j) * 128 + d];
      m = mn;
    }
    if (dbad(p.nk[(size_t)(bh * 128 + k) * 128 + d], n, 0.01f, 0.01f)) dfail(p, 9);
    if (dbad(p.mk[bh * 129 + k], m, 1e-3f, 1e-2f)) dfail(p, 38);
    {
      const int c = 1 + (h >> 17) % 3, dv = (h >> 20) & 255, dk = d, b = bh >> 2, hh = bh & 3;
      float mm = 0.f, C = 0.f;
      for (int j = 0; j < c; ++j) {
        const int tok0 = b * SEQ + j * 64;
        float B = 0.f;
        for (int s = 0; s < 64; ++s) B += p.gates[(size_t)(tok0 + s) * 8 + 4 + hh];
        float bs = 0.f, ml = -INFINITY;
        for (int s = 0; s < 64; ++s) { bs += p.gates[(size_t)(tok0 + s) * 8 + 4 + hh]; ml = fmaxf(ml, B - bs + p.gates[(size_t)(tok0 + s) * 8 + hh]); }
        bs = 0.f; float u = 0.f;
        for (int s = 0; s < 64; ++s) {
          bs += p.gates[(size_t)(tok0 + s) * 8 + 4 + hh];
          u += expf(B - bs + p.gates[(size_t)(tok0 + s) * 8 + hh] - ml) * bf2f(p.proj[(size_t)(tok0 + s) * 2048 + 512 + hh * 128 + dk]) * bf2f(p.vt[((size_t)(bh * 256 + dv)) * SEQ + j * 64 + s]);
        }
        const float mn = fmaxf(B + mm, ml);
        C = expf(B + mm - mn) * C + expf(ml - mn) * u; mm = mn;
      }
      if (dbad(bf2f(p.uck[((size_t)((bh * 128 + c) * 256 + dv)) * 128 + dk]), C, 0.03f, 0.5f)) dfail(p, 39);
      if (bf2f(p.uck[((size_t)((bh * 128 + 0) * 256 + dv)) * 128 + dk]) != 0.f) dfail(p, 40);
    }
  } else if (ph == 9) {
    const int bh = h & 7, c = (h >> 3) & 127, t = (h >> 10) & 63, dvs = (h >> 16) & 255, b = bh >> 2, hh = bh & 3;
    const int tok0 = b * SEQ + c * 64, tk = tok0 + t;
    float* qk = (float*)dsm + tid * 64;
    const float mk = p.mk[bh * 129 + c];
    float bt = 0.f, G = -INFINITY;
    for (int s = 0; s <= t; ++s) {
      bt += p.gates[(size_t)(tok0 + s) * 8 + 4 + hh];
      const float g = p.gates[(size_t)(tok0 + s) * 8 + hh] - bt; G = fmaxf(G, g);
      float a = 0.f;
      for (int d = 0; d < 128; ++d) a += bf2f(p.proj[(size_t)tk * 2048 + hh * 128 + d]) * bf2f(p.proj[(size_t)(tok0 + s) * 2048 + 512 + hh * 128 + d]);
      qk[s] = a;
      qk[s] = a * 1.0f;
    }
    const float M = fmaxf(mk, G), wi = expf(mk - M), emt = expf(-(bt + M));
    { float b2 = 0.f; for (int s = 0; s <= t; ++s) { b2 += p.gates[(size_t)(tok0 + s) * 8 + 4 + hh]; qk[s] *= expf(p.gates[(size_t)(tok0 + s) * 8 + hh] - b2 - M); } }
    float den = 0.f;
    for (int s = 0; s <= t; ++s) den += qk[s];
    { float qn = 0.f; for (int d = 0; d < 128; ++d) qn += bf2f(p.proj[(size_t)tk * 2048 + hh * 128 + d]) * p.nk[(size_t)(bh * 128 + c) * 128 + d]; den += wi * qn; }
    const float inv = 1.f / fmaxf(fabsf(den), emt);
    float s1 = 0.f, s2 = 0.f, hs = 0.f;
    for (int dv = 0; dv < 256; ++dv) {
      float num = 0.f;
      for (int s = 0; s <= t; ++s) num += qk[s] * bf2f(p.vt[((size_t)(bh * 256 + dv)) * SEQ + c * 64 + s]);
      float qc = 0.f;
      for (int d = 0; d < 128; ++d) qc += bf2f(p.proj[(size_t)tk * 2048 + hh * 128 + d]) * bf2f(p.uck[((size_t)((bh * 128 + c) * 256 + dv)) * 128 + d]);
      const float hv = (num + wi * qc) * inv;
      s1 += hv; s2 += hv * hv; if (dv == dvs) hs = hv;
    }
    const float mu = s1 / 256.f, var = s2 / 256.f - mu * mu;
    const float o = ddot(p.H + (size_t)tk * D, p.in[I_MLWIN] + 2048 + hh * 256 + dvs, 3080, 1024);
    const float want = (hs - mu) * rsqrtf(var + LN_EPS) * p.in[I_MLNW][hh * 256 + dvs] / (1.f + expf(-o));
    if (dbad(bf2f(p.proj[(size_t)tk * 2048 + 1024 + hh * 256 + dvs]), want, 0.05f, 1.0f)) dfail(p, 10);
  } else if (ph == 18) {
    const int col = (h >> 12) % 1024, d = col & 63;
    float v = ddot(p.H + (size_t)tok * D, p.in[I_ATTWQ] + col, 1024, 1024);
    if (d < 16) {
      const int pcol = d < 8 ? col + 8 : col - 8;
      const float v2 = ddot(p.H + (size_t)tok * D, p.in[I_ATTWQ] + pcol, 1024, 1024);
      const float ang = (float)((double)pos_of(tok) * p.inv_freq[d & 7]);
      v = d < 8 ? v * cosf(ang) - v2 * sinf(ang) : v * cosf(ang) + v2 * sinf(ang);
    }
    if (dbad(bf2f(p.q[(size_t)tok * D + col]), v * 0.125f, 0.03f, 0.2f)) dfail(p, 19);
  } else if (ph == 19) {
    const int qh = (h >> 12) & 15, d = (h >> 16) & 63, kvh = qh >> 2;
    const float sink = p.in[I_SINKS][qh];
    const bf16* qp = p.q + (size_t)tok * D + qh * 64;
    float mx = sink, want;
    if (tok < TP) {
      const int b = tok >> 13, pos = tok & 8191;
      for (int pass = 0; pass < 2; ++pass) {
        float sum = 0.f, o = 0.f;
        for (int kp = pos - 127; kp <= pos; ++kp) {
          if (kp < 0) continue;
          float a = 0.f;
          for (int e = 0; e < 64; ++e) a += bf2f(qp[e]) * bf2f(p.ks[(size_t)(b * SEQ + kp) * 256 + kvh * 64 + e]);
          if (pass == 0) mx = fmaxf(mx, a);
          else { const float w = expf(a - mx); sum += w; o += w * bf2f(p.vta[((size_t)((b * 4 + kvh) * 64 + d)) * SEQ + kp]); }
        }
        want = o / (sum + expf(sink - mx));
      }
    } else {
      const int b = (tok - TP) >> 2, t = (tok - TP) & 3;
      for (int pass = 0; pass < 2; ++pass) {
        float sum = 0.f, o = 0.f;
        for (int key = 0; key < 132; ++key) {
          const bool valid = key < 128 ? (key > t) : ((key - 128) <= t);
          if (!valid) continue;
          const float* kp = key < 128 ? p.in[I_CK] + ((size_t)(b * 128 + key) * 4 + kvh) * 64 : p.out + O_WKS + ((size_t)(b * 128 + 124 + key - 128) * 4 + kvh) * 64;
          const float* vp = key < 128 ? p.in[I_CV] + ((size_t)(b * 128 + key) * 4 + kvh) * 64 : p.out + O_WVS + ((size_t)(b * 128 + 124 + key - 128) * 4 + kvh) * 64;
          float a = 0.f;
          for (int e = 0; e < 64; ++e) a += bf2f(qp[e]) * kp[e];
          if (pass == 0) mx = fmaxf(mx, a);
          else { const float w = expf(a - mx); sum += w; o += w * vp[d]; }
        }
        want = o / (sum + expf(sink - mx));
      }
    }
    if (dbad(bf2f(p.att[(size_t)tok * D + qh * 64 + d]), want, 0.03f, 0.3f)) dfail(p, 20);
  }
}
#endif

#define XB_TMO      128
#define XB_XCNT(j)  (256  + 64 * (j))
#define XB_XSUB(j)  (1280 + 64 * (j))
#define XB_XGEN(j)  (2304 + 64 * (j))
#define XB_TOP      3328
#define XB_TOPGEN   3392
#define XCD_BAR_WORDS 3456
#define XB_SPIN_CAP (1u << 18)
__device__ __forceinline__ unsigned xb_ld(unsigned* p)              { return __hip_atomic_load(p, __ATOMIC_RELAXED, __HIP_MEMORY_SCOPE_AGENT); }
__device__ __forceinline__ unsigned xb_add(unsigned* p, unsigned v) { return __hip_atomic_fetch_add(p, v, __ATOMIC_RELAXED, __HIP_MEMORY_SCOPE_AGENT); }
__device__ __forceinline__ unsigned xb_xcc_id() { return (unsigned)__builtin_amdgcn_s_getreg((3 << 11) | 20) & 0xFu; }
#define XB_SPIN(cond, bar) do { unsigned _sp = 0; while (cond) { __builtin_amdgcn_s_sleep(1); \
    if ((++_sp & 255u) == 0u) { if (xb_ld(&(bar)[XB_TMO])) break; if (_sp > XB_SPIN_CAP) { atomicAdd(&(bar)[XB_TMO], 1u); break; } } } } while (0)
struct XcdBarrier { unsigned* bar; unsigned x; volatile LAS unsigned* st; };
__device__ __forceinline__ XcdBarrier xcd_barrier_post(unsigned* bar, volatile LAS unsigned* st) {
  XcdBarrier b; b.bar = bar; b.x = xb_xcc_id(); b.st = st;
  if (threadIdx.x == 0) (void)xb_add(&bar[XB_XCNT(b.x)], 1u);
  return b;
}
__device__ __forceinline__ void xcd_barrier_complete(unsigned* bar, unsigned x, unsigned& nloc, unsigned& nx) {
  const unsigned G = gridDim.x * gridDim.y * gridDim.z;
  unsigned sum, cnt, mine, sp = 0u;
  for (;;) {
    sum = 0u; cnt = 0u; mine = 0u;
#pragma unroll
    for (unsigned j = 0; j < 16; ++j) { const unsigned c = xb_ld(&bar[XB_XCNT(j)]); sum += c; cnt += (c > 0u) ? 1u : 0u; mine = (j == x) ? c : mine; }
    if (sum == G) break;
    __builtin_amdgcn_s_sleep(1);
    if ((++sp & 255u) == 0u) { if (xb_ld(&bar[XB_TMO])) break; if (sp > XB_SPIN_CAP) { atomicAdd(&bar[XB_TMO], 1u); break; } }
  }
  nloc = mine > 0u ? mine : 1u; nx = cnt > 0u ? cnt : 1u;
}
__device__ __forceinline__ void xcd_barrier(const XcdBarrier& b) {
  asm volatile("s_waitcnt vmcnt(0)" ::: "memory");
  __syncthreads();
  if (threadIdx.x == 0) {
    unsigned* bar = b.bar;
    __builtin_amdgcn_s_waitcnt(0);
    unsigned nloc = b.st[0], nx = b.st[1];
    if (nloc == 0u) { xcd_barrier_complete(bar, b.x, nloc, nx); b.st[0] = nloc; b.st[1] = nx; }
    const unsigned old = xb_add(&bar[XB_XSUB(b.x)], 1u);
    const unsigned gen = old / nloc;
    if (old + 1u == (gen + 1u) * nloc) {
      __builtin_amdgcn_fence(__ATOMIC_RELEASE, "agent");
      asm volatile("s_waitcnt vmcnt(0)" ::: "memory");
      const unsigned og = xb_add(&bar[XB_TOP], 1u);
      const unsigned tg = og / nx;
      if (og + 1u == (tg + 1u) * nx) xb_add(&bar[XB_TOPGEN], 1u);
      else XB_SPIN(xb_ld(&bar[XB_TOPGEN]) == tg, bar);
      __builtin_amdgcn_fence(__ATOMIC_ACQUIRE, "agent");
      xb_add(&bar[XB_XGEN(b.x)], 1u);
      asm volatile("s_waitcnt vmcnt(0)" ::: "memory");
    } else {
      XB_SPIN(xb_ld(&bar[XB_XGEN(b.x)]) == gen, bar);
      __builtin_amdgcn_fence(__ATOMIC_ACQUIRE, "agent");
      asm volatile("s_waitcnt vmcnt(0)" ::: "memory");
    }
  }
  __syncthreads();
}

__global__ void __launch_bounds__(NTHR, 2) yoco_megakernel(Params p_unused) {
  cg::grid_group grid = cg::this_grid();
  __shared__ __attribute__((aligned(16))) char smem[LDS_BYTES];
  __shared__ uint4 xb_words;
  const __attribute__((address_space(4))) Params* pbase0 = (const __attribute__((address_space(4))) Params*)__builtin_amdgcn_kernarg_segment_ptr();
  unsigned* barw = pbase0->bar;
  if (threadIdx.x == 0) xb_words = make_uint4(0u, 0u, 0u, 0u);
  if (blockIdx.x == 0) for (int i = threadIdx.x; i < XCD_BAR_WORDS; i += NTHR) barw[i] = 0u;
  __syncthreads();
  XcdBarrier xb; xb.bar = barw; xb.x = 0u; xb.st = (volatile LAS unsigned*)&xb_words;
  bool posted = false;
  enum { K_PREP = 0, K_ADA, K_LN, K_UP, K_RES, K_MLIN, K_MLA, K_SCAN, K_MLC, K_Q, K_ATT };
  constexpr int NPH = 25;
  const __attribute__((address_space(4))) Params* pbase = (const __attribute__((address_space(4))) Params*)__builtin_amdgcn_kernarg_segment_ptr();
#pragma unroll 1
  for (int step = 0; step < NPH * PROBE_REP; ++step) {
    const int ph = step / PROBE_REP;
    const bool dry = (PROBE_REP == 2) && ((step & 1) == 0);
    if (dry && !((PROBE_MASK >> ph) & 1)) continue;
    const __attribute__((address_space(4))) Params* pp = pbase;
    asm volatile("" : "+s"(pp));
    PRef p = *pp;
    int kind = K_LN;
    int layer = ph >= 15 ? 1 : 0;
    const int lo = layer * 9216;
    int ffn = 0;
    int res_kind = 0;
    LnArgs la = LnArgs{0, layer, 0, -1, -1, 0, 0, 0, 0.f, 0};
    switch (ph) {
      case 0: kind = K_PREP; break;
      case 1: kind = K_ADA; break;
      case 2: la = LnArgs{1, 0, 0, 0, -1, 0, 0, 0, 0.f, 0}; break;
      case 3: case 15: kind = K_UP; ffn = 0; break;
      case 4: case 16: kind = K_RES; ffn = 0; break;
      case 5: la = LnArgs{0, 0, 0, 3 * 1024, -1, 1, 0, 0, 0.f, 0}; break;
      case 17: la = LnArgs{0, 1, 0, 9216 + 3 * 1024, -1, 0, 0, 0, 0.f, 0}; break;
      case 6: kind = K_MLIN; break;
      case 7: kind = K_MLA; break;
      case 8: kind = K_SCAN; break;
      case 9: kind = K_MLC; break;
      case 10: case 20: kind = K_RES; res_kind = 1; break;
      case 11: la = LnArgs{0, 0, 1, 6 * 1024, -1, 0, 0, 0, 0.f, 0}; break;
      case 21: la = LnArgs{0, 1, 1, 9216 + 6 * 1024, -1, 0, 0, 0, 0.f, 0}; break;
      case 12: case 22: kind = K_UP; ffn = 1; break;
      case 13: case 23: kind = K_RES; ffn = 1; break;
      case 14: la = LnArgs{0, 0, 2, 9216, 18432, 0, 0, 0, 0.f, 0}; break;
      case 18: kind = K_Q; break;
      case 19: kind = K_ATT; break;
      case 24: la = LnArgs{0, 1, 2, -1, -1, 0, 0, 0, 0.f, 0}; break;
      default: break;
    }
    if (ph == 5) la.xfirst = 1;
    if (ph == 5 || ph == 17) { la.nsl = 11; la.pgoff = lo + 2 * 1024; la.pwgt = 0.5f; }
    if (ph == 14 || ph == 24) { la.nsl = 11; la.pgoff = lo + 8 * 1024; la.pwgt = 0.5f; }
    if (ph == 11 || ph == 21) { la.nsl = 4; la.pgoff = lo + 5 * 1024; la.pwgt = 1.0f; }
    switch (kind) {
      case K_PREP: phase_prep(p, smem); break;
      case K_ADA: {
        GArgs g = GArgs{p.cact, 1024, p.wt_ada, 1024, 256, MODW, 0, 0.f, ALPHA, 1024, 0, 0, p.out};
        gemm_phase<M_ADA>(p, g, smem);
      } break;
      case K_LN: if (dry) la.src_input = 2; ln_phase(p, la, smem); break;
      case K_UP: {
        const int wi = layer * 2 + ffn;
        const bf16* w = wi == 0 ? p.wt_up[0] : wi == 1 ? p.wt_up[1] : wi == 2 ? p.wt_up[2] : p.wt_up[3];
        GArgs g = GArgs{p.H, 1024, w, 1024, T, 2 * F, 0, 0.f, ALPHA, 1024, 0, 0, p.out};
        gemm_phase<M_SWIGLU>(p, g, smem);
        if (ph == 15) {
          GArgs g2 = GArgs{p.hkv, 1024, p.wt_kv, 1024, T, 512, 0, 0.f, ALPHA, 1024, opq_gdim(), opq_gdim() - 1 - opq_bid(), p.out};
          gemm_phase<M_KV>(p, g2, smem);
        }
      } break;
      case K_RES: {
        GArgs g;
        if (res_kind == 0) {
          const int wi = layer * 2 + ffn;
          const bf16* w = wi == 0 ? p.wt_down[0] : wi == 1 ? p.wt_down[1] : wi == 2 ? p.wt_down[2] : p.wt_down[3];
          g = GArgs{p.hid, F, w, F, T, 1024, lo + (ffn ? 8 : 2) * 1024, 0.5f, ALPHA, F, 0, 0, p.out};
        } else if (layer == 0) {
          g = GArgs{p.H, 1024, p.wt_mlout, 1024, T, 1024, lo + 5 * 1024, 1.0f, ALPHA, 1024, 0, 0, p.out};
        } else {
          g = GArgs{p.att, 1024, p.wt_o, 1024, T, 1024, lo + 5 * 1024, 1.0f, ALPHA, 1024, 0, 0, p.out};
        }
        if (ph == 4) g.xsrc = p.in[I_XP];
        if (dry) { g.alpha = 1.0f; g.wgt = 0.0f; g.xsrc = p.out; }
        g.M = TP;
        gemm_phase<M_RES>(p, g, smem);
        {
          const int nsl = g.K / 256, bid = opq_bid();
          if (bid < 8 * nsl) {
            const int sl = bid >> 3;
            GArgs g2 = GArgs{g.A + (size_t)TP * g.lda + sl * 256, g.lda, g.Bt + sl * 256, 256, 512, 1024, sl, 0.f, 0.f, g.K, 8, bid & 7, p.out};
            gemm_phase<M_PART>(p, g2, smem);
          }
        }
      } break;
      case K_MLIN: {
        GArgs g = GArgs{p.H, 1024, p.wt_mlin, 1024, TP, 3072, 0, 0.f, ALPHA, 1024, 0, 0, p.out};
        gemm_phase<M_MLIN>(p, g, smem);
        {
          const int bid = opq_bid();
          if (bid < 96) {
            const int sl = bid / 24;
            GArgs g2 = GArgs{p.H + (size_t)TP * 1024 + sl * 256, 1024, p.wt_mlin + sl * 256, 256, 512, 3072, sl, 0.f, 0.f, 1024, 24, bid % 24, p.out};
            gemm_phase<M_PART>(p, g2, smem);
          }
        }
      } break;
      case K_MLA:
        for (int it = vq_bid(); it < 1024; it += vq_gdim()) mlstm_A_item(p, it, smem + vq_vb() * VLDS);
        if (vq_gdim() != 512) for (int it = vq_bid(); it < 512; it += vq_gdim()) mlstm_sample_item(p, it, smem + vq_vb() * VLDS, dry);
        break;
      case K_SCAN:
        if (vq_gdim() == 512 && vq_bid() >= 256) { for (int it = vq_bid() - 256; it < 512; it += 256) mlstm_sample_item(p, it, smem + vq_vb() * VLDS, dry); }
        else mlstm_scan_phase(p, smem + vq_vb() * VLDS, dry);
        break;
      case K_MLC:
        for (int it = vq_bid(); it < 1024; it += vq_gdim()) mlstm_C_item(p, it, smem + vq_vb() * VLDS, dry);
        break;
      case K_Q: {
        GArgs g = GArgs{p.H, 1024, p.wt_q, 1024, TP, 1024, 0, 0.f, ALPHA, 1024, 0, 0, p.out};
        gemm_phase<M_Q>(p, g, smem);
        {
          const int bid = opq_bid();
          if (bid < 32) {
            const int sl = bid >> 3;
            GArgs g2 = GArgs{p.H + (size_t)TP * 1024 + sl * 256, 1024, p.wt_q + sl * 256, 256, 512, 1024, sl, 0.f, 0.f, 1024, 8, bid & 7, p.out};
            gemm_phase<M_PART>(p, g2, smem);
          }
        }
      } break;
      case K_ATT:
        for (int it = vq_bid(); it < 512; it += vq_gdim()) attn_prompt_item(p, it, smem + vq_vb() * VLDS);
        for (int it = vq_bid(); it < 512; it += vq_gdim()) attn_sample_item(p, it, smem + vq_vb() * VLDS);
        break;
      default: break;
    }
#ifdef SELFCHECK
    grid.sync();
    if (blockIdx.x == 0) {
      if (ph == 0 && threadIdx.x == 0) *p.dbg = 1000;
      __syncthreads();
      selfcheck(p, ph, smem);
    }
    grid.sync();
    if (ph + 1 == NPH && blockIdx.x == 0 && threadIdx.x == 0) {
      const int code = *p.dbg;
      if (code != 1000) p.out[0] = 1e4f * exp10f(0.4f * (float)code);
    }
#else
    if (step + 1 < NPH * PROBE_REP) {
      if (!posted) {
        grid.sync();
        xb = xcd_barrier_post(barw, (volatile LAS unsigned*)&xb_words);
        posted = true;
      } else { xcd_barrier(xb); if (PROBE_SYNC2) xcd_barrier(xb); }
    }
#endif
  }
}

extern "C" void kernel_launch(void* const* d_in, const int* in_sizes, int n_in, void* d_out, int out_size, void* d_ws, size_t ws_size, hipStream_t stream) {
  Params p;
  std::memset((void*)&p, 0, sizeof(p));
  for (int i = 0; i < 27; ++i) p.in[i] = (const float*)d_in[i];
  p.out = (float*)d_out;
  char* ws = (char*)d_ws;
  size_t off = 0;
  auto alloc = [&](size_t bytes) { char* r = ws + off; off += (bytes + 255) & ~(size_t)255; return r; };
  p.wt_ada = (bf16*)alloc((size_t)MODW * 1024 * 2);
  for (int i = 0; i < 4; ++i) p.wt_up[i] = (bf16*)alloc((size_t)5632 * 1024 * 2);
  for (int i = 0; i < 4; ++i) p.wt_down[i] = (bf16*)alloc((size_t)1024 * F * 2);
  p.wt_mlin = (bf16*)alloc((size_t)3072 * 1024 * 2);
  p.wt_mlout = (bf16*)alloc((size_t)1024 * 1024 * 2);
  p.wt_kv = (bf16*)alloc((size_t)512 * 1024 * 2);
  p.wt_q = (bf16*)alloc((size_t)1024 * 1024 * 2);
  p.wt_o = (bf16*)alloc((size_t)1024 * 1024 * 2);
  p.cact = (bf16*)alloc((size_t)256 * 1024 * 2);
  p.mods = (float*)alloc((size_t)NBR * MODW * 4);
  p.rot = (float2*)alloc((size_t)8196 * 8 * 8);
  p.H = (bf16*)alloc((size_t)T * 1024 * 2);
  p.gates = (float*)alloc((size_t)T * 8 * 4);
  char* arena = ws + off;
  size_t aoff = 0;
  auto aalloc = [&](size_t bytes) { char* r = arena + aoff; aoff += (bytes + 255) & ~(size_t)255; return r; };
  p.hid = (bf16*)arena;
  p.proj = (bf16*)aalloc((size_t)T * 2048 * 2);
  p.q = (bf16*)arena;
  p.att = (bf16*)(arena + (size_t)T * 1024 * 2);
  p.kt = (bf16*)aalloc((size_t)8 * 128 * SEQ * 2);
  p.vt = (bf16*)aalloc((size_t)8 * 256 * SEQ * 2);
  p.hkv = (bf16*)aalloc((size_t)T * 1024 * 2);
  p.ks = (bf16*)aalloc((size_t)T * 256 * 2);
  p.vta = (bf16*)aalloc((size_t)8 * 64 * SEQ * 2);
  size_t save = aoff;
  aoff = (size_t)((char*)p.hkv - arena);
  p.uck = (bf16*)aalloc((size_t)8 * 128 * 256 * 128 * 2);
  if (aoff < save) aoff = save;
  p.vsamp = (bf16*)aalloc((size_t)512 * 1024 * 2);
  p.un = (float*)aalloc((size_t)8 * 128 * 128 * 4);
  p.nk = (float*)aalloc((size_t)8 * 128 * 128 * 4);
  p.ab = (float*)aalloc((size_t)8 * 128 * 2 * 4);
  p.mk = (float*)aalloc((size_t)8 * 129 * 4);
  p.bar = (unsigned*)aalloc(XCD_BAR_WORDS * 4);
  p.part = (float*)aalloc((size_t)4 * 512 * 3072 * 4);
  p.dbg = (int*)aalloc(256);
  p.stash = (float*)aalloc(4096);
  int ts = 0, wi = 0;
  auto addw = [&](const float* src, bf16* dst, int K, int N, int ld, int mode) {
    p.wd[wi].src = src; p.wd[wi].dst = dst; p.wd[wi].K = K; p.wd[wi].N = N; p.wd[wi].ld = ld; p.wd[wi].tstart = ts; p.wd[wi].mode = mode;
    ts += (K / 64) * (N / 64); ++wi;
  };
  const float* const* in = (const float* const*)d_in;
  addw(in[I_ADAW], p.wt_ada, 1024, 9216, 9216, 0);
  addw(in[I_ADAW] + (size_t)1024 * 9216, p.wt_ada + (size_t)9216 * 1024, 1024, 9216, 9216, 0);
  addw(in[I_KVADAW], p.wt_ada + (size_t)18432 * 1024, 1024, 2048, 2048, 0);
  for (int l = 0; l < 2; ++l) {
    addw(in[I_F1U] + (size_t)l * 1024 * 5632, p.wt_up[l * 2 + 0], 1024, 5632, 5632, 1 | (l ? 2 : 0));
    addw(in[I_F2U] + (size_t)l * 1024 * 5632, p.wt_up[l * 2 + 1], 1024, 5632, 5632, 1 | (l ? 2 : 0));
    addw(in[I_F1D] + (size_t)l * F * 1024, p.wt_down[l * 2 + 0], F, 1024, 1024, (l ? 2 : 0));
    addw(in[I_F2D] + (size_t)l * F * 1024, p.wt_down[l * 2 + 1], F, 1024, 1024, (l ? 2 : 0));
  }
  addw(in[I_MLWIN], p.wt_mlin, 1024, 1024, 3080, 0);
  addw(in[I_MLWIN] + 2048, p.wt_mlin + (size_t)1024 * 1024, 1024, 1024, 3080, 0);
  addw(in[I_MLWIN] + 1024, p.wt_mlin + (size_t)2048 * 1024, 1024, 1024, 3080, 0);
  addw(in[I_MLWOUT], p.wt_mlout, 1024, 1024, 1024, 0);
  addw(in[I_KVW], p.wt_kv, 1024, 512, 512, 2);
  addw(in[I_ATTWQ], p.wt_q, 1024, 1024, 1024, 2);
  addw(in[I_ATTWO], p.wt_o, 1024, 1024, 1024, 2);
  p.wd_total = ts;
  for (; wi < 20; ++wi) p.wd[wi].tstart = 0x7fffffff;
  for (int i = 0; i < 8; ++i) p.inv_freq[i] = pow(500000.0, -(double)i / 8.0);

  static int grid_blocks = 0;
  if (!grid_blocks) {
    int dev = 0, cus = 0, per_cu = 0;
    (void)hipGetDevice(&dev);
    (void)hipDeviceGetAttribute(&cus, hipDeviceAttributeMultiprocessorCount, dev);
    (void)hipOccupancyMaxActiveBlocksPerMultiprocessor(&per_cu, yoco_megakernel, NTHR, 0);
    if (per_cu > 1) per_cu = 1;
    if (per_cu < 1) per_cu = 1;
    grid_blocks = cus * per_cu;
    grid_blocks &= ~7;
  }
  void* args[] = {&p};
  hipError_t e = hipLaunchCooperativeKernel((void*)yoco_megakernel, dim3(grid_blocks), dim3(NTHR), args, 0, stream);
  if (e != hipSuccess) fprintf(stderr, "cooperative launch failed: %s (grid %d)\n", hipGetErrorString(e), grid_blocks);
}
```
